# Optimizing an MI355X kernel written in HIP

```python
import jax, jax.numpy as jnp
from jax import lax
import numpy as np

D_MODEL = 1024
BATCH = 16
SEQ = 256
DEPTH = 1
DEC_BATCH = 8
DEC_SEQ = 2048
PAST_LEN = 512

GRID_W = 64
N_HEADS = 16
N_KV_HEADS = 4
HEAD_DIM = 64
ATT_WIDTH = N_HEADS * HEAD_DIM
KV_WIDTH = N_KV_HEADS * HEAD_DIM
CONV_WIDTH = D_MODEL
CONV_K = 3
D_FF = 2816
Q_BLOCK = 128
ROPE_THETA = 10000.0
AXIS_DIM = HEAD_DIM // 2
N_ADA = 6
EPS = 1e-6
IN_SPLITS = (ATT_WIDTH, KV_WIDTH, KV_WIDTH, CONV_WIDTH, CONV_WIDTH, CONV_WIDTH, D_MODEL, D_MODEL)
IN_WIDTH = 3 * CONV_WIDTH + ATT_WIDTH + 2 * KV_WIDTH + 2 * D_MODEL

kernel_name = "hybrid_diffusion_prefix_gqa_shortconv_step"


def rms_norm(x, g):
    xf = x.astype(jnp.float32)
    y = xf * lax.rsqrt(jnp.mean(xf * xf, axis=-1, keepdims=True) + EPS)
    return (y * g.astype(jnp.float32)).astype(x.dtype)


def dwconv3(x, w):
    xp = jnp.pad(x, ((0, 0), (1, 1), (0, 0)))
    return w[0] * xp[:, :-2] + w[1] * xp[:, 1:-1] + w[2] * xp[:, 2:]


def axial_rope_tables(n):
    rows = n // GRID_W
    row = jnp.repeat(jnp.arange(rows, dtype=jnp.float32), GRID_W)
    col = jnp.tile(jnp.arange(GRID_W, dtype=jnp.float32), rows)
    inv = jnp.power(ROPE_THETA, -jnp.arange(0, AXIS_DIM, 2, dtype=jnp.float32) / AXIS_DIM)
    ang_r = row[:, None] * inv[None, :]
    ang_c = col[:, None] * inv[None, :]
    return (jnp.cos(ang_r), jnp.sin(ang_r), jnp.cos(ang_c), jnp.sin(ang_c))


def _rotate(xh, cos, sin):
    half = xh.shape[-1] // 2
    x1, x2 = xh[..., :half], xh[..., half:]
    c = cos[None, :, None, :]
    s = sin[None, :, None, :]
    return jnp.concatenate([x1 * c - x2 * s, x1 * s + x2 * c], axis=-1)


def apply_axial_rope(x, tabs):
    cr, sr, cc, sc = tabs
    xf = x.astype(jnp.float32)
    out = jnp.concatenate([_rotate(xf[..., :AXIS_DIM], cr, sr), _rotate(xf[..., AXIS_DIM:], cc, sc)], axis=-1)
    return out.astype(x.dtype)


def block_attention(q, k, v):
    B, N, H, D = q.shape
    KV = k.shape[2]
    G = H // KV
    qb_len = Q_BLOCK if N % Q_BLOCK == 0 else N
    nb = N // qb_len
    scale = D ** -0.5
    qb = q.reshape(B, nb, qb_len, KV, G, D).transpose(1, 0, 2, 3, 4, 5)

    def one_block(qblk):
        s = jnp.einsum('bqkgd,btkd->bkgqt', qblk, k).astype(jnp.float32) * scale
        p = jax.nn.softmax(s, axis=-1).astype(v.dtype)
        return jnp.einsum('bkgqt,btkd->bqkgd', p, v)

    o = lax.map(one_block, qb)
    return o.transpose(1, 0, 2, 3, 4, 5).reshape(B, N, H * D)


def mixer(u, p, rope_tabs, ctx_k, ctx_v):
    B, N, _ = u.shape
    z = u @ p["w_in"]
    idx = np.cumsum(np.array(IN_SPLITS))[:-1].tolist()
    q, k, v, b_gate, c_gate, x_in, g_att, g_conv = jnp.split(z, idx, axis=-1)
    q = rms_norm(q.reshape(B, N, N_HEADS, HEAD_DIM), p["q_norm"])
    k = rms_norm(k.reshape(B, N, N_KV_HEADS, HEAD_DIM), p["k_norm"])
    v = v.reshape(B, N, N_KV_HEADS, HEAD_DIM)
    if rope_tabs is None:
        q_used, keys, vals = q, k, v
    else:
        q_used = apply_axial_rope(q, rope_tabs)
        keys = jnp.concatenate([ctx_k.astype(k.dtype), apply_axial_rope(k, rope_tabs)], axis=1)
        vals = jnp.concatenate([ctx_v.astype(v.dtype), v], axis=1)
    att = block_attention(q_used, keys, vals) @ p["w_att_out"]
    conv = (b_gate * dwconv3(c_gate * x_in, p["conv_w"])) @ p["w_conv_out"]
    merged = jax.nn.sigmoid(g_att) * att + jax.nn.sigmoid(g_conv) * conv
    return merged @ p["w_o"], k, v


def conv_ffn(u, p):
    up = dwconv3(u @ p["w_up"], p["conv_ffn"])
    g, val = jnp.split(up, 2, axis=-1)
    return (jax.nn.silu(g) * val) @ p["w_down"]


def trunk_layer(h, ada, p, rope_tabs, ctx_k, ctx_v):
    sh1, sc1, g1, sh2, sc2, g2 = jnp.split(ada, N_ADA, axis=-1)
    u = rms_norm(h, p["g_pre1"]) * (1 + sc1) + sh1
    mo, k, v = mixer(u, p, rope_tabs, ctx_k, ctx_v)
    h = h + g1 * rms_norm(mo, p["g_post1"])
    u = rms_norm(h, p["g_pre2"]) * (1 + sc2) + sh2
    h = h + g2 * rms_norm(conv_ffn(u, p), p["g_post2"])
    return h, k, v


def setup_inputs(seed: int = 0) -> dict:
    key = jax.random.key(seed)
    ks = jax.random.split(key, 24)
    f32 = jnp.float32
    nrm = lambda k, shape, s: (jax.random.normal(k, shape, f32) * s)
    gain = lambda k, shape: 1.0 + 0.05 * jax.random.normal(k, shape, f32)
    return {
        "x_prompt": nrm(ks[0], (BATCH, SEQ, D_MODEL), 1.0),
        "x_sample": nrm(ks[1], (DEC_BATCH, DEC_SEQ, D_MODEL), 1.0),
        "cache_k": nrm(ks[2], (DEC_BATCH, DEPTH, PAST_LEN, N_KV_HEADS, HEAD_DIM), 1.0),
        "cache_v": nrm(ks[3], (DEC_BATCH, DEPTH, PAST_LEN, N_KV_HEADS, HEAD_DIM), 1.0),
        "c": nrm(ks[4], (DEC_BATCH, D_MODEL), 1.0),
        "c_ctx": nrm(ks[5], (D_MODEL,), 1.0),
        "w_ada": nrm(ks[6], (DEPTH, D_MODEL, N_ADA * D_MODEL), 0.5 * D_MODEL ** -0.5),
        "b_ada": nrm(ks[7], (DEPTH, N_ADA * D_MODEL), 0.01),
        "g_pre1": gain(ks[8], (DEPTH, D_MODEL)),
        "g_post1": gain(ks[9], (DEPTH, D_MODEL)),
        "g_pre2": gain(ks[10], (DEPTH, D_MODEL)),
        "g_post2": gain(ks[11], (DEPTH, D_MODEL)),
        "w_in": nrm(ks[12], (DEPTH, D_MODEL, IN_WIDTH), D_MODEL ** -0.5),
        "q_norm": gain(ks[13], (DEPTH, HEAD_DIM)),
        "k_norm": gain(ks[14], (DEPTH, HEAD_DIM)),
        "w_att_out": nrm(ks[15], (DEPTH, ATT_WIDTH, D_MODEL), ATT_WIDTH ** -0.5),
        "conv_w": nrm(ks[16], (DEPTH, CONV_K, CONV_WIDTH), CONV_K ** -0.5),
        "w_conv_out": nrm(ks[17], (DEPTH, CONV_WIDTH, D_MODEL), CONV_WIDTH ** -0.5),
        "w_o": nrm(ks[18], (DEPTH, D_MODEL, D_MODEL), D_MODEL ** -0.5),
        "w_up": nrm(ks[19], (DEPTH, D_MODEL, 2 * D_FF), D_MODEL ** -0.5),
        "conv_ffn": nrm(ks[20], (DEPTH, CONV_K, 2 * D_FF), CONV_K ** -0.5),
        "w_down": nrm(ks[21], (DEPTH, D_FF, D_MODEL), D_FF ** -0.5),
    }


def reference(x_prompt, x_sample, cache_k, cache_v, c, c_ctx, w_ada, b_ada, g_pre1, g_post1, g_pre2, g_post2,
              w_in, q_norm, k_norm, w_att_out, conv_w, w_conv_out, w_o, w_up, conv_ffn, w_down):
    rope_tabs = axial_rope_tables(x_sample.shape[1])
    h_p = x_prompt
    h_s = x_sample
    new_ks = []
    new_vs = []
    for i in range(DEPTH):
        p = {
            "g_pre1": g_pre1[i], "g_post1": g_post1[i], "g_pre2": g_pre2[i], "g_post2": g_post2[i],
            "w_in": w_in[i], "q_norm": q_norm[i], "k_norm": k_norm[i], "w_att_out": w_att_out[i],
            "conv_w": conv_w[i], "w_conv_out": w_conv_out[i], "w_o": w_o[i],
            "w_up": w_up[i], "conv_ffn": conv_ffn[i], "w_down": w_down[i],
        }
        ada_ctx = (jax.nn.silu(c_ctx) @ w_ada[i] + b_ada[i])[None, None, :]
        ada_lat = (jax.nn.silu(c) @ w_ada[i] + b_ada[i])[:, None, :]
        h_p, k_ctx, v_ctx = trunk_layer(h_p, ada_ctx, p, None, None, None)
        new_ks.append(k_ctx)
        new_vs.append(v_ctx)
        h_s, _, _ = trunk_layer(h_s, ada_lat, p, rope_tabs, cache_k[:, i], cache_v[:, i])
    new_k = jnp.stack(new_ks, axis=1)
    new_v = jnp.stack(new_vs, axis=1)
    return (h_p, h_s, new_k, new_v)
```

```cpp
#include <hip/hip_runtime.h>
#include <hip/hip_cooperative_groups.h>
#include <cstdio>
#include <cstdint>
namespace cg = cooperative_groups;
__device__ __forceinline__ int lane_id_() { unsigned m = ~0u; asm volatile("" : "+s"(m)); return (int)__builtin_amdgcn_mbcnt_hi(m, __builtin_amdgcn_mbcnt_lo(m, 0u)); }
template <int X> __device__ __forceinline__ float lx(float v) { return __builtin_bit_cast(float, __builtin_amdgcn_ds_swizzle(__builtin_bit_cast(int, v), (X << 10) | 0x1F)); }
__device__ __forceinline__ void swap32(float v, float& lo, float& hi) { float a = v, b = v; asm volatile("s_nop 1\n\tv_permlane32_swap_b32 %0, %1\n\ts_nop 1" : "+v"(a), "+v"(b)); lo = a; hi = b; }
__device__ __forceinline__ float lsum32(float v) { float lo, hi; swap32(v, lo, hi); return lo + hi; }
__device__ __forceinline__ float lmax32(float v) { float lo, hi; swap32(v, lo, hi); return fmaxf(lo, hi); }
__device__ __forceinline__ float lother32(float v, bool low_half) { float lo, hi; swap32(v, lo, hi); return low_half ? hi : lo; }
namespace pg8 {
#define PG8_LAS __attribute__((address_space(3)))
typedef unsigned short bf16_t;
typedef short bf16x8 __attribute__((ext_vector_type(8)));
typedef float f32x4 __attribute__((ext_vector_type(4)));
typedef unsigned u32x4 __attribute__((ext_vector_type(4)));
constexpr int BM = 256, BK = 64, HALF = 128, HTB = HALF * BK * 2  , STAGE_BYTES = 8 * HTB, NXCD = 8, WGM = 8;

__host__ __device__ __forceinline__ int lds_byte(int r, int c) { const int st = (r >> 4) * 2 + (c >> 5), rr = r & 15, cc = c & 31, ob = rr * 64 + cc * 2; return st * 1024 + (ob ^ (((ob >> 9) & 1) << 5)); }
__host__ __device__ __forceinline__ void stage_rc(int b, int& R, int& C) { const int st = b / 1024, sb = b % 1024, swz = sb ^ (((sb >> 9) & 1) << 5); R = (st >> 1) * 16 + swz / 64; C = (st & 1) * 32 + (swz % 64) / 2; }
__host__ __device__ __forceinline__ int perm32(int rho) { const int n = rho >> 4, i = rho & 15; return 8 * (i >> 2) + 4 * n + (i & 3); }

struct Unit { int pm, pn; };
struct Gemm { const bf16_t* A; const bf16_t* Bt; int M, N, K; };

struct StaticOrder {
    int nM, nN, nwg, G, c;
    __host__ __device__ void init(int M, int N, int G_, int c_) { nM = M / BM; nN = N / BM; nwg = nM * nN; G = G_; c = c_; }
    __host__ __device__ bool next(int i, Unit& u) const {
        const long L = (long)i * G + c; if (L >= nwg) return false;
        int wgid = (int)L; { const int q = nwg / NXCD, r = nwg % NXCD, xcd = wgid % NXCD, off = wgid / NXCD; wgid = (xcd < r ? xcd * (q + 1) : r * (q + 1) + (xcd - r) * q) + off; }
        const int nig = WGM * nN, gid = wgid / nig, fm = gid * WGM, gsz = (nM - fm) < WGM ? (nM - fm) : WGM;
        u.pm = fm + ((wgid % nig) % gsz); u.pn = (wgid % nig) / gsz; return true;
    }
    __device__ __forceinline__ void a_ready(const Unit&) const {}
    __device__ __forceinline__ void done(const Unit&) const {}
};

__device__ __forceinline__ unsigned cvt_pk_bf16(float lo, float hi) { unsigned r; asm volatile("v_cvt_pk_bf16_f32 %0, %1, %2" : "=v"(r) : "v"(lo), "v"(hi)); return r; }
typedef float f32x2 __attribute__((ext_vector_type(2)));
template <class Epi, class Sched, bool ALIGN_EPI = false, bool SP2 = false>
__device__ __forceinline__ void gemm_phase(PG8_LAS unsigned char* lds, const Gemm g, const Sched& S, const Epi& E) {
    int tid = S.wid * 64 + lane_id_(); asm volatile("" : "+v"(tid)); const int wid = __builtin_amdgcn_readfirstlane(tid >> 6), lane = tid & 63, wr = wid >> 2, wc = wid & 3, fr = lane & 15, fq = lane >> 4;
    const int K = g.K, nt = K / BK;
    unsigned voffA[2], voffB[2];
#pragma unroll
    for (int i = 0; i < 2; ++i) { int R, C; stage_rc(tid * 16 + i * 8192, R, C); const int Rb = Epi::PERM ? ((R & ~31) + perm32(R & 31)) : R;
        voffA[i] = (unsigned)(R * K + C) * 2u; voffB[i] = (unsigned)(Rb * K + C) * 2u; }
    const size_t kstep = (size_t)(BK * 2);
    const size_t hstep = (size_t)HALF * K * 2;
    const size_t tstep = 2 * hstep;
    const unsigned ldsw = (unsigned)wid * 1024u;
    const int aoff = lds_byte(wr * 64 + fr, fq * 8), boff = lds_byte(wc * 32 + fr, fq * 8);
#define PG8_SA(b, h) (((b) * 2 + (h)) * HTB)
#define PG8_SB(b, h) ((4 + (b) * 2 + (h)) * HTB)
#define PG8_STAGE(bufoff, gbase, voff) do { _Pragma("unroll") for (int _i = 0; _i < 2; ++_i) \
        __builtin_amdgcn_global_load_lds((const unsigned*)((const char*)(gbase) + (voff)[_i]), (PG8_LAS unsigned*)(lds + (bufoff) + ldsw + _i * 8192), 16, 0, 0); } while (0)
#define PG8_LDA(dst, b, h) do { _Pragma("unroll") for (int m = 0; m < 4; ++m) _Pragma("unroll") for (int k = 0; k < 2; ++k) dst[m][k] = *(const PG8_LAS bf16x8*)(lds + PG8_SA(b, h) + aoff + m * 2048 + k * 1024); } while (0)
#define PG8_LDB(dst, b, h) do { _Pragma("unroll") for (int n = 0; n < 2; ++n) _Pragma("unroll") for (int k = 0; k < 2; ++k) dst[n][k] = *(const PG8_LAS bf16x8*)(lds + PG8_SB(b, h) + boff + n * 2048 + k * 1024); } while (0)
#define PG8_MMA(ai, bj, At, Bt) do { __builtin_amdgcn_s_setprio(1); _Pragma("unroll") for (int m = 0; m < 4; ++m) _Pragma("unroll") for (int n = 0; n < 2; ++n) _Pragma("unroll") for (int k = 0; k < 2; ++k) \
        acc[ai][bj][m][n] = __builtin_amdgcn_mfma_f32_16x16x32_bf16(Bt[n][k], At[m][k], acc[ai][bj][m][n], 0, 0, 0); __builtin_amdgcn_s_setprio(0); } while (0)
#define PG8_WAIT_V(n) asm volatile("s_waitcnt vmcnt(" #n ")" ::: "memory")
#define PG8_WAIT_L(n) asm volatile("s_waitcnt lgkmcnt(" #n ")" ::: "memory")
#define PG8_BAR __builtin_amdgcn_s_barrier()
#define PG8_SCHED __builtin_amdgcn_sched_barrier(0)
    Unit cur, nxt; int ui = 0;
    if (!S.next(0, cur)) return;
    f32x4 acc[2][2][4][2];
#pragma unroll
    for (int a = 0; a < 2; ++a)
#pragma unroll
        for (int b = 0; b < 2; ++b)
#pragma unroll
            for (int m = 0; m < 4; ++m)
#pragma unroll
                for (int n = 0; n < 2; ++n) acc[a][b][m][n] = (f32x4){0.f, 0.f, 0.f, 0.f};
    bf16x8 At[4][2], B0[2][2], B1[2][2];
    const char* cA = (const char*)g.A + (size_t)cur.pm * tstep; const char* cB = (const char*)g.Bt + (size_t)cur.pn * tstep;
    S.a_ready(cur);
    if constexpr (SP2) {
        PG8_STAGE(PG8_SB(0, 0), cB, voffB); PG8_STAGE(PG8_SB(0, 1), cB + hstep, voffB); PG8_STAGE(PG8_SA(0, 0), cA, voffA); PG8_STAGE(PG8_SA(0, 1), cA + hstep, voffA);
        if (wr == 1) PG8_BAR;
        PG8_WAIT_V(2); PG8_BAR;
        PG8_STAGE(PG8_SB(1, 0), cB + kstep, voffB); PG8_STAGE(PG8_SA(1, 0), cA + kstep, voffA); PG8_STAGE(PG8_SB(1, 1), cB + hstep + kstep, voffB);
        PG8_WAIT_V(6); PG8_BAR;
    } else {
        PG8_STAGE(PG8_SB(0, 0), cB, voffB); PG8_STAGE(PG8_SA(0, 0), cA, voffA); PG8_STAGE(PG8_SB(0, 1), cB + hstep, voffB); PG8_STAGE(PG8_SA(0, 1), cA + hstep, voffA);
        if (wr == 1) PG8_BAR;
        PG8_WAIT_V(4); PG8_BAR;
        PG8_STAGE(PG8_SB(1, 0), cB + kstep, voffB); PG8_STAGE(PG8_SA(1, 0), cA + kstep, voffA); PG8_STAGE(PG8_SB(1, 1), cB + hstep + kstep, voffB);
        PG8_WAIT_V(6); PG8_BAR;
    }
    for (;;) {
        const bool has_next = S.next(ui + 1, nxt);
        const char* nA = has_next ? (const char*)g.A + (size_t)nxt.pm * tstep : cA; const char* nB = has_next ? (const char*)g.Bt + (size_t)nxt.pn * tstep : cB;
        for (int t = 0; t < nt; t += 2) {
            const bool last = (t == nt - 2);
            const char* a1 = cA + (size_t)(t + 1) * kstep;
            const char* a2 = last ? nA : cA + (size_t)(t + 2) * kstep; const char* b2 = last ? nB : cB + (size_t)(t + 2) * kstep;
            const char* a3 = a2 + kstep; const char* b3 = b2 + kstep;
            if (last && has_next) S.a_ready(nxt);
            if constexpr (SP2) {
            PG8_LDB(B0, 0, 0); PG8_LDB(B1, 0, 1); PG8_SCHED; PG8_LDA(At, 0, 0); PG8_STAGE(PG8_SA(1, 1), a1 + hstep, voffA);
            PG8_WAIT_V(8); PG8_WAIT_L(0); PG8_BAR; PG8_MMA(0, 0, At, B0); PG8_MMA(0, 1, At, B1); PG8_BAR; PG8_SCHED;
            PG8_LDA(At, 0, 1); PG8_STAGE(PG8_SB(0, 0), b2, voffB); PG8_STAGE(PG8_SB(0, 1), b2 + hstep, voffB); PG8_STAGE(PG8_SA(0, 0), a2, voffA);
            PG8_WAIT_V(8); PG8_WAIT_L(0); PG8_BAR; PG8_MMA(1, 0, At, B0); PG8_MMA(1, 1, At, B1); PG8_BAR; PG8_SCHED;
            PG8_LDB(B0, 1, 0); PG8_LDB(B1, 1, 1); PG8_SCHED; PG8_LDA(At, 1, 0); PG8_STAGE(PG8_SA(0, 1), a2 + hstep, voffA);
            PG8_WAIT_V(8); PG8_WAIT_L(0); PG8_BAR; PG8_MMA(0, 0, At, B0); PG8_MMA(0, 1, At, B1); PG8_BAR; PG8_SCHED;
            PG8_LDA(At, 1, 1); PG8_STAGE(PG8_SB(1, 0), b3, voffB); PG8_STAGE(PG8_SB(1, 1), b3 + hstep, voffB); PG8_STAGE(PG8_SA(1, 0), a3, voffA);
            PG8_WAIT_V(8); PG8_WAIT_L(0); PG8_BAR; PG8_MMA(1, 0, At, B0); PG8_MMA(1, 1, At, B1); PG8_BAR; PG8_SCHED;
            } else {
            PG8_LDB(B0, 0, 0); PG8_SCHED; PG8_LDA(At, 0, 0); PG8_STAGE(PG8_SA(1, 1), a1 + hstep, voffA);
            PG8_WAIT_L(8); PG8_BAR; PG8_WAIT_L(0); PG8_MMA(0, 0, At, B0); PG8_BAR; PG8_SCHED;
            PG8_LDB(B1, 0, 1); PG8_STAGE(PG8_SB(0, 0), b2, voffB);
            PG8_BAR; PG8_WAIT_L(0); PG8_MMA(0, 1, At, B1); PG8_BAR;
            PG8_LDA(At, 0, 1); PG8_STAGE(PG8_SA(0, 0), a2, voffA);
            PG8_BAR; PG8_WAIT_L(0); PG8_MMA(1, 0, At, B0); PG8_BAR; PG8_SCHED;
            PG8_STAGE(PG8_SB(0, 1), b2 + hstep, voffB);
            PG8_WAIT_V(6); PG8_BAR; PG8_MMA(1, 1, At, B1); PG8_BAR;
            PG8_LDB(B0, 1, 0); PG8_SCHED; PG8_LDA(At, 1, 0); PG8_STAGE(PG8_SA(0, 1), a2 + hstep, voffA);
            PG8_WAIT_L(8); PG8_BAR; PG8_WAIT_L(0); PG8_MMA(0, 0, At, B0); PG8_BAR; PG8_SCHED;
            PG8_LDB(B1, 1, 1); PG8_STAGE(PG8_SB(1, 0), b3, voffB);
            PG8_BAR; PG8_WAIT_L(0); PG8_MMA(0, 1, At, B1); PG8_BAR;
            PG8_LDA(At, 1, 1); PG8_STAGE(PG8_SA(1, 0), a3, voffA);
            PG8_BAR; PG8_WAIT_L(0); PG8_MMA(1, 0, At, B0); PG8_BAR; PG8_SCHED;
            PG8_STAGE(PG8_SB(1, 1), b3 + hstep, voffB);
            PG8_WAIT_V(6); PG8_BAR; PG8_MMA(1, 1, At, B1); PG8_BAR;
            }
        }
        if constexpr (ALIGN_EPI) { if (wr == 0) PG8_BAR; }
        if constexpr (!Epi::AFTER_DRAIN) { E(acc, cur, wr, wc, fr, fq); S.done(cur); }
        if (!has_next) break;
#pragma unroll
        for (int a = 0; a < 2; ++a)
#pragma unroll
            for (int b = 0; b < 2; ++b)
#pragma unroll
                for (int m = 0; m < 4; ++m)
#pragma unroll
                    for (int n = 0; n < 2; ++n) acc[a][b][m][n] = (f32x4){0.f, 0.f, 0.f, 0.f};
        cur = nxt; cA = nA; cB = nB; ++ui;
        if constexpr (ALIGN_EPI) { if (wr == 1) PG8_BAR; }
    }
    PG8_WAIT_V(0);
    if constexpr (!ALIGN_EPI) { if (wr == 0) PG8_BAR; }
    PG8_BAR;
    if constexpr (Epi::AFTER_DRAIN) { E.fused(acc, cur, wr, wc, fr, fq, lds, wid, lane); S.done(cur); }
#undef PG8_SA
#undef PG8_SB
#undef PG8_STAGE
#undef PG8_LDA
#undef PG8_LDB
#undef PG8_MMA
#undef PG8_WAIT_V
#undef PG8_WAIT_L
#undef PG8_BAR
#undef PG8_SCHED
}
}

#define LAS __attribute__((address_space(3)))
typedef unsigned short bf16;
typedef float f32x4 __attribute__((ext_vector_type(4)));
typedef float f32x16 __attribute__((ext_vector_type(16)));
typedef short bf16x8 __attribute__((ext_vector_type(8)));
typedef short s16x4 __attribute__((ext_vector_type(4)));
typedef unsigned u32x4 __attribute__((ext_vector_type(4)));
typedef unsigned u32x2 __attribute__((ext_vector_type(2)));

constexpr int NTHR = 512;
constexpr int TP = 4096, TS = 16384, T = 20480, D = 1024, NIN = 6656, NUP = 5632, DFF = 2816;
constexpr int LSAMP = 2560, KVW = 256;
constexpr float EPS = 1e-6f;
constexpr float C2 = 0.125f * 1.4426950408889634f;
constexpr size_t MiB = 1u << 20;
constexpr size_t WS_BAR = 65536, WS_BAR_BYTES = 16384;
constexpr size_t WS_KMAX = 1 * MiB + 256 * 1024;
constexpr size_t WS_ADA = 1 * MiB, WS_WIN = 2 * MiB, WS_WATT = 15 * MiB, WS_WCONV = 17 * MiB, WS_WO = 19 * MiB, WS_WUP = 21 * MiB, WS_WDN = 32 * MiB,
    WS_U = 38 * MiB, WS_Q = 78 * MiB, WS_CX = 118 * MiB, WS_B = 158 * MiB, WS_KP = 198 * MiB, WS_VP = 200 * MiB, WS_KS = 202 * MiB, WS_VS = 212 * MiB,
    WS_KRAW = 222 * MiB, WS_VRAW = 232 * MiB,
    WS_UP = 78 * MiB, WS_ACT = 188 * MiB,
    WS_ACTF = 78 * MiB, WS_HALO = 190 * MiB, WS_MO = 198 * MiB;
constexpr int CHUNK = 10240;
constexpr int LDS_BYTES = 148480;

typedef float f32x2_t __attribute__((ext_vector_type(2)));
typedef __bf16 bf16x2_t __attribute__((ext_vector_type(2)));
__device__ __forceinline__ unsigned pk2(float lo, float hi) { f32x2_t v = {lo, hi}; bf16x2_t b = __builtin_convertvector(v, bf16x2_t); return __builtin_bit_cast(unsigned, b); }
__device__ __forceinline__ float bflo(unsigned w) { return __builtin_bit_cast(float, w << 16); }
__device__ __forceinline__ float bfhi(unsigned w) { return __builtin_bit_cast(float, w & 0xffff0000u); }
__device__ __forceinline__ float fexp2(float x) { return __builtin_amdgcn_exp2f(x); }
__device__ __forceinline__ float sigmoidf_(float x) { return __builtin_amdgcn_rcpf(1.f + fexp2(-1.4426950408889634f * x)); }
__device__ __forceinline__ float wave_sum(float v) { v += lx<1>(v); v += lx<2>(v); v += lx<4>(v); v += lx<8>(v); v += lx<16>(v); return lsum32(v); }
__device__ __forceinline__ float wave_max(float v) { v = fmaxf(v, lx<1>(v)); v = fmaxf(v, lx<2>(v)); v = fmaxf(v, lx<4>(v)); v = fmaxf(v, lx<8>(v)); v = fmaxf(v, lx<16>(v)); return lmax32(v); }
#define LDS_WAIT() asm volatile("s_waitcnt lgkmcnt(0)" ::: "memory")
#define XB_TMO      128
#define XB_XCNT(j)  (256  + 64 * (j))
#define XB_XSUB(j)  (1280 + 64 * (j))
#define XB_XGEN(j)  (2304 + 64 * (j))
#define XB_TOP      3328
#define XB_TOPGEN   3392
#define XCD_BAR_WORDS 3456
#define XB_SPIN_CAP (1u << 18)

__device__ __forceinline__ unsigned xb_ld(unsigned* p)              { return __hip_atomic_load(p, __ATOMIC_RELAXED, __HIP_MEMORY_SCOPE_AGENT); }
__device__ __forceinline__ unsigned xb_add(unsigned* p, unsigned v) { return __hip_atomic_fetch_add(p, v, __ATOMIC_RELAXED, __HIP_MEMORY_SCOPE_AGENT); }
__device__ __forceinline__ unsigned xb_xcc_id() { return (unsigned)__builtin_amdgcn_s_getreg((3 << 11) | 20) & 0xFu; }
#define XB_SPIN(cond, bar) do { unsigned _sp = 0; while (cond) { __builtin_amdgcn_s_sleep(1); \
    if ((++_sp & 255u) == 0u) { if (xb_ld(&(bar)[XB_TMO])) break; if (_sp > XB_SPIN_CAP) { atomicAdd(&(bar)[XB_TMO], 1u); break; } } } } while (0)

struct XcdBarrier {
    int w;
    unsigned* bar; unsigned x;
    volatile LAS unsigned* st;
};

__device__ __forceinline__ XcdBarrier xcd_barrier_post(unsigned* bar, volatile LAS unsigned* st, int w) {
    XcdBarrier b; b.w = w; b.bar = bar; b.x = xb_xcc_id(); b.st = st;
    if (threadIdx.x == 0) (void)xb_add(&bar[XB_XCNT(b.x)], 1u);
    return b;
}
__device__ __forceinline__ void xcd_barrier_complete(unsigned* bar, unsigned x, unsigned& nloc, unsigned& nx) {
    const unsigned G = gridDim.x * gridDim.y * gridDim.z;
    unsigned sum, cnt, mine, sp = 0u;
    for (;;) {
        sum = 0u; cnt = 0u; mine = 0u;
#pragma unroll
        for (unsigned j = 0; j < 16; ++j) { const unsigned c = xb_ld(&bar[XB_XCNT(j)]); sum += c; cnt += (c > 0u) ? 1u : 0u; mine = (j == x) ? c : mine; }
        if (sum == G) break;
        __builtin_amdgcn_s_sleep(1);
        if ((++sp & 255u) == 0u) { if (xb_ld(&bar[XB_TMO])) break; if (sp > XB_SPIN_CAP) { atomicAdd(&bar[XB_TMO], 1u); break; } }
    }
    nloc = mine > 0u ? mine : 1u; nx = cnt > 0u ? cnt : 1u;
}

__device__ __forceinline__ void xcd_barrier(const XcdBarrier& b) {
    asm volatile("s_waitcnt vmcnt(0)" ::: "memory");
    __syncthreads();
    if (b.w == 0 && lane_id_() == 0) {
        unsigned* bar = b.bar;
        __builtin_amdgcn_s_waitcnt(0);
        unsigned nloc = b.st[0], nx = b.st[1];
        if (nloc == 0u) { xcd_barrier_complete(bar, b.x, nloc, nx); b.st[0] = nloc; b.st[1] = nx; }
        const unsigned old = xb_add(&bar[XB_XSUB(b.x)], 1u);
        const unsigned gen = old / nloc;
        if (old + 1u == (gen + 1u) * nloc) {
            __builtin_amdgcn_fence(__ATOMIC_RELEASE, "agent");
            asm volatile("s_waitcnt vmcnt(0)" ::: "memory");
            const unsigned og = xb_add(&bar[XB_TOP], 1u);
            const unsigned tg = og / nx;
            if (og + 1u == (tg + 1u) * nx) xb_add(&bar[XB_TOPGEN], 1u);
            else XB_SPIN(xb_ld(&bar[XB_TOPGEN]) == tg, bar);
            __builtin_amdgcn_fence(__ATOMIC_ACQUIRE, "agent");
            xb_add(&bar[XB_XGEN(b.x)], 1u);
            asm volatile("s_waitcnt vmcnt(0)" ::: "memory");
        } else {
            XB_SPIN(xb_ld(&bar[XB_XGEN(b.x)]) == gen, bar);
            __builtin_amdgcn_fence(__ATOMIC_ACQUIRE, "agent");
            asm volatile("s_waitcnt vmcnt(0)" ::: "memory");
        }
    }
    __syncthreads();
}

struct Params {
    const float *x_prompt, *x_sample, *cache_k, *cache_v, *c, *c_ctx, *w_ada, *b_ada, *g_pre1, *g_post1, *g_pre2, *g_post2, *w_in, *q_norm, *k_norm,
        *w_att_out, *conv_w, *w_conv_out, *w_o, *w_up, *conv_ffn, *w_down;
    float* out; unsigned char* ws;
};

__device__ __forceinline__ u32x4 pack8v(const f32x4 a, const f32x4 b) { u32x4 w; w.x = pk2(a[0], a[1]); w.y = pk2(a[2], a[3]); w.z = pk2(b[0], b[1]); w.w = pk2(b[2], b[3]); return w; }
__device__ __forceinline__ f32x4 sig4(const f32x4 v) { return (f32x4){sigmoidf_(v[0]), sigmoidf_(v[1]), sigmoidf_(v[2]), sigmoidf_(v[3])}; }
__device__ __forceinline__ f32x4 lo4(const u32x4 w) { return (f32x4){bflo(w.x), bfhi(w.x), bflo(w.y), bfhi(w.y)}; }
__device__ __forceinline__ f32x4 hi4(const u32x4 w) { return (f32x4){bflo(w.z), bfhi(w.z), bflo(w.w), bfhi(w.w)}; }
template <int CTRL> __device__ __forceinline__ float dppf(float old, float src) { return __builtin_bit_cast(float, __builtin_amdgcn_update_dpp(__builtin_bit_cast(int, old), __builtin_bit_cast(int, src), CTRL, 0xf, 0xf, false)); }
__device__ __forceinline__ f32x4 rowprev4(const f32x4 x, const f32x4 wrap) { return (f32x4){dppf<0x111>(wrap[0], x[0]), dppf<0x111>(wrap[1], x[1]), dppf<0x111>(wrap[2], x[2]), dppf<0x111>(wrap[3], x[3])}; }
__device__ __forceinline__ f32x4 rownext4(const f32x4 x, const f32x4 wrap) { return (f32x4){dppf<0x101>(wrap[0], x[0]), dppf<0x101>(wrap[1], x[1]), dppf<0x101>(wrap[2], x[2]), dppf<0x101>(wrap[3], x[3])}; }
__device__ __forceinline__ f32x4 ror1_4(const f32x4 x) { return (f32x4){dppf<0x121>(0.f, x[0]), dppf<0x121>(0.f, x[1]), dppf<0x121>(0.f, x[2]), dppf<0x121>(0.f, x[3])}; }
__device__ __forceinline__ f32x4 ror15_4(const f32x4 x) { return (f32x4){dppf<0x12F>(0.f, x[0]), dppf<0x12F>(0.f, x[1]), dppf<0x12F>(0.f, x[2]), dppf<0x12F>(0.f, x[3])}; }
struct EpiU {
    static constexpr bool PERM = true, AFTER_DRAIN = false;
    int mode, ld; bf16* O; size_t rowoff; const bf16 *X1, *X2; LAS unsigned char* xl; const __attribute__((address_space(4))) Params* kp;
    __device__ __forceinline__ void operator()(const f32x4 (&acc)[2][2][4][2], const pg8::Unit& u, int wr, int wc, int fr, int fq) const {
        const int pn = u.pn, row0 = u.pm * 256 + wr * 64 + fr, cw = wc * 32 + 8 * fq;
        unsigned char* const ws = kp->ws; float* const outp = kp->out; bf16* const GA = (bf16*)outp;
        if (mode == 0) {
            if (pn >= 10 && pn < 18) {
                bf16* CX = (bf16*)(ws + WS_CX);
#pragma unroll
                for (int ai = 0; ai < 2; ++ai)
#pragma unroll
                    for (int m = 0; m < 4; ++m)
                        *(u32x4*)(CX + (size_t)(row0 + ai * 128 + m * 16) * D + (pn - 10) * 128 + cw) = pack8v(acc[ai][0][m][0] * acc[ai][1][m][0], acc[ai][0][m][1] * acc[ai][1][m][1]);
            } else if (pn < 5) {
                const bool isq = pn < 4, samp = u.pm >= 16; const float* gn = isq ? kp->q_norm : kp->k_norm; const int hcol = (isq ? (4 * pn + wc) : wc) * 64 + 8 * fq;
                const LAS float* tab = (const LAS float*)(xl + 8192);
                const float sgn = fq < 2 ? -1.f : 1.f, qs = isq ? C2 : 1.f; const int kidx = 8 * (fq & 1);
#pragma unroll
                for (int ai = 0; ai < 2; ++ai)
#pragma unroll
                    for (int m = 0; m < 4; ++m) {
                        const int row = row0 + ai * 128 + m * 16;
                        f32x4 v00 = acc[ai][0][m][0], v01 = acc[ai][0][m][1], v10 = acc[ai][1][m][0], v11 = acc[ai][1][m][1];
                        const f32x4 sq = v00 * v00 + v01 * v01 + v10 * v10 + v11 * v11; float ss = (sq[0] + sq[1]) + (sq[2] + sq[3]);
                        ss += lx<16>(ss); ss = lsum32(ss);
                        const float rstd = rsqrtf(ss * (1.f / 64.f) + EPS);
                        v00 = v00 * rstd * *(const f32x4*)(gn + 8 * fq); v01 = v01 * rstd * *(const f32x4*)(gn + 8 * fq + 4); v10 = v10 * rstd * *(const f32x4*)(gn + 32 + 8 * fq); v11 = v11 * rstd * *(const f32x4*)(gn + 32 + 8 * fq + 4);
                        if (samp) {
                            const int t = (row - TP) & 2047;
                            { const LAS float* tr = tab + (t >> 6) * 32 + kidx; const f32x4 c0 = *(const LAS f32x4*)tr, c1 = *(const LAS f32x4*)(tr + 4), s0 = *(const LAS f32x4*)(tr + 16), s1 = *(const LAS f32x4*)(tr + 20);
                              f32x4 o0, o1;
#pragma unroll
                              for (int i = 0; i < 4; ++i) { o0[i] = lother32(v00[i], fq < 2); o1[i] = lother32(v01[i], fq < 2); }
                              v00 = v00 * c0 + (o0 * s0) * sgn; v01 = v01 * c1 + (o1 * s1) * sgn; }
                            __builtin_amdgcn_sched_barrier(0);
                            { const LAS float* tc = tab + (t & 63) * 32 + kidx; const f32x4 c0 = *(const LAS f32x4*)tc, c1 = *(const LAS f32x4*)(tc + 4), s0 = *(const LAS f32x4*)(tc + 16), s1 = *(const LAS f32x4*)(tc + 20);
                              f32x4 o0, o1;
#pragma unroll
                              for (int i = 0; i < 4; ++i) { o0[i] = lother32(v10[i], fq < 2); o1[i] = lother32(v11[i], fq < 2); }
                              v10 = v10 * c0 + (o0 * s0) * sgn; v11 = v11 * c1 + (o1 * s1) * sgn; }
                        }
                        if (isq) { bf16* q = (bf16*)(ws + WS_Q) + (size_t)row * D + hcol; *(u32x4*)q = pack8v(v00 * qs, v01 * qs); *(u32x4*)(q + 32) = pack8v(v10 * qs, v11 * qs); }
                        else if (!samp) { bf16* k = (bf16*)(ws + WS_KP) + (size_t)row * KVW + hcol; *(u32x4*)k = pack8v(v00, v01); *(u32x4*)(k + 32) = pack8v(v10, v11);
                            float* nk = outp + (size_t)T * D + (size_t)row * KVW + hcol; *(f32x4*)nk = v00; *(f32x4*)(nk + 4) = v01; *(f32x4*)(nk + 32) = v10; *(f32x4*)(nk + 36) = v11; }
                        else { const int b = (row - TP) >> 11, t = (row - TP) & 2047; bf16* k = (bf16*)(ws + WS_KS) + ((size_t)b * LSAMP + 512 + t) * KVW + hcol; *(u32x4*)k = pack8v(v00, v01); *(u32x4*)(k + 32) = pack8v(v10, v11); }
                        __builtin_amdgcn_sched_barrier(0);
                    }
            } else if (pn == 5) {
                const bool samp = u.pm >= 16;
#pragma unroll
                for (int ai = 0; ai < 2; ++ai)
#pragma unroll
                    for (int m = 0; m < 4; ++m)
#pragma unroll
                        for (int bj = 0; bj < 2; ++bj) { const int row = row0 + ai * 128 + m * 16, c = bj * 128 + cw; const f32x4 v0 = acc[ai][bj][m][0], v1 = acc[ai][bj][m][1];
                            if (!samp) { *(u32x4*)((bf16*)(ws + WS_VP) + (size_t)row * KVW + c) = pack8v(v0, v1); float* nv = outp + (size_t)T * D + (size_t)TP * KVW + (size_t)row * KVW + c; *(f32x4*)nv = v0; *(f32x4*)(nv + 4) = v1; }
                            else { const int b = (row - TP) >> 11, t = (row - TP) & 2047; *(u32x4*)((bf16*)(ws + WS_VS) + ((size_t)b * LSAMP + 512 + t) * KVW + c) = pack8v(v0, v1); } }
            } else {
                if (pn >= 18) {
                    unsigned char* G8 = (unsigned char*)outp + (pn >= 22 ? (size_t)T * D : 0); const int cb = (pn >= 22 ? pn - 22 : pn - 18) * 256;
#pragma unroll
                    for (int ai = 0; ai < 2; ++ai)
#pragma unroll
                        for (int m = 0; m < 4; ++m)
#pragma unroll
                            for (int bj = 0; bj < 2; ++bj) { const f32x4 v0 = sig4(acc[ai][bj][m][0]) * 255.f + 0.5f, v1 = sig4(acc[ai][bj][m][1]) * 255.f + 0.5f;
                                u32x2 w; w.x = (unsigned)v0[0] | ((unsigned)v0[1] << 8) | ((unsigned)v0[2] << 16) | ((unsigned)v0[3] << 24); w.y = (unsigned)v1[0] | ((unsigned)v1[1] << 8) | ((unsigned)v1[2] << 16) | ((unsigned)v1[3] << 24);
                                *(u32x2*)(G8 + (size_t)(row0 + ai * 128 + m * 16) * D + cb + bj * 128 + cw) = w; }
                } else {
                    bf16* Op = (bf16*)(ws + WS_B); const int cb = (pn - 6) * 256;
#pragma unroll
                    for (int ai = 0; ai < 2; ++ai)
#pragma unroll
                        for (int m = 0; m < 4; ++m)
#pragma unroll
                            for (int bj = 0; bj < 2; ++bj) *(u32x4*)(Op + (size_t)(row0 + ai * 128 + m * 16) * D + cb + bj * 128 + cw) = pack8v(acc[ai][bj][m][0], acc[ai][bj][m][1]);
                }
            }
        } else if (mode == 5) {
            LAS float* XCH = (LAS float*)xl;
            const int colw = wc * 32 + 8 * fq;
            if (fr == 0) {
#pragma unroll
                for (int ai = 0; ai < 2; ++ai)
#pragma unroll
                    for (int bj = 0; bj < 2; ++bj)
#pragma unroll
                        for (int n = 0; n < 2; ++n) *(LAS f32x4*)(XCH + ((2 * ai + wr) * 2 + 0) * 256 + bj * 128 + colw + 4 * n) = acc[ai][bj][0][n];
            }
            if (fr == 15) {
#pragma unroll
                for (int ai = 0; ai < 2; ++ai)
#pragma unroll
                    for (int bj = 0; bj < 2; ++bj)
#pragma unroll
                        for (int n = 0; n < 2; ++n) *(LAS f32x4*)(XCH + ((2 * ai + wr) * 2 + 1) * 256 + bj * 128 + colw + 4 * n) = acc[ai][bj][3][n];
            }
            LDS_WAIT(); __builtin_amdgcn_s_barrier(); asm volatile("" ::: "memory");
            bf16* ACT = (bf16*)(ws + WS_ACTF); float* HALO = (float*)(ws + WS_HALO); const float* cf = kp->conv_ffn;
            const int jc = pn * 128 + wc * 32 + 16 * (fq & 1) + 4 * (fq >> 1);
#pragma unroll
            for (int n = 0; n < 2; ++n) {
                const f32x4 wg0 = *(const f32x4*)(cf + jc + 8 * n), wg1 = *(const f32x4*)(cf + NUP + jc + 8 * n), wg2 = *(const f32x4*)(cf + 2 * NUP + jc + 8 * n);
                const f32x4 wv0 = *(const f32x4*)(cf + DFF + jc + 8 * n), wv1 = *(const f32x4*)(cf + NUP + DFF + jc + 8 * n), wv2 = *(const f32x4*)(cf + 2 * NUP + DFF + jc + 8 * n);
#pragma unroll
                for (int ai = 0; ai < 2; ++ai) {
                    const int seg = 2 * ai + wr;
                    u32x2 keep;
#pragma unroll
                    for (int m = 0; m < 4; ++m) {
                        const f32x4 z4 = {0.f, 0.f, 0.f, 0.f};
                        const f32x4 xg = acc[ai][0][m][n];
                        f32x4 wp = z4, wn = z4;
                        if (m == 0) { if (seg > 0) wp = *(const LAS f32x4*)(XCH + ((seg - 1) * 2 + 1) * 256 + colw + 4 * n); } else wp = ror1_4(acc[ai][0][m == 0 ? 0 : m - 1][n]);
                        if (m == 3) { if (seg < 3) wn = *(const LAS f32x4*)(XCH + ((seg + 1) * 2 + 0) * 256 + colw + 4 * n); } else wn = ror15_4(acc[ai][0][m == 3 ? 3 : m + 1][n]);
                        const f32x4 cg = wg0 * rowprev4(xg, wp) + wg1 * xg + wg2 * rownext4(xg, wn);
                        __builtin_amdgcn_sched_barrier(0);
                        const f32x4 xv = acc[ai][1][m][n];
                        wp = z4; wn = z4;
                        if (m == 0) { if (seg > 0) wp = *(const LAS f32x4*)(XCH + ((seg - 1) * 2 + 1) * 256 + 128 + colw + 4 * n); } else wp = ror1_4(acc[ai][1][m == 0 ? 0 : m - 1][n]);
                        if (m == 3) { if (seg < 3) wn = *(const LAS f32x4*)(XCH + ((seg + 1) * 2 + 0) * 256 + 128 + colw + 4 * n); } else wn = ror15_4(acc[ai][1][m == 3 ? 3 : m + 1][n]);
                        const f32x4 cv = wv0 * rowprev4(xv, wp) + wv1 * xv + wv2 * rownext4(xv, wn);
                        if (seg == 0 && m == 0 && fr == 0) { float* h = HALO + (size_t)((u.pm * 2 + 0) * 4) * DFF + jc + 8 * n; *(f32x4*)h = cg; *(f32x4*)(h + DFF) = cv; *(f32x4*)(h + 2 * DFF) = xg; *(f32x4*)(h + 3 * DFF) = xv; }
                        if (seg == 3 && m == 3 && fr == 15) { float* h = HALO + (size_t)((u.pm * 2 + 1) * 4) * DFF + jc + 8 * n; *(f32x4*)h = cg; *(f32x4*)(h + DFF) = cv; *(f32x4*)(h + 2 * DFF) = xg; *(f32x4*)(h + 3 * DFF) = xv; }
                        const f32x4 a = cg * sig4(cg) * cv;
                        u32x2 w; w.x = pk2(a[0], a[1]); w.y = pk2(a[2], a[3]);
                        if ((m & 1) == 0) keep = w;
                        else {
                            asm volatile("s_nop 1\n\tv_permlane32_swap_b32 %0, %1\n\ts_nop 1" : "+v"(keep.x), "+v"(w.x));
                            asm volatile("s_nop 1\n\tv_permlane32_swap_b32 %0, %1\n\ts_nop 1" : "+v"(keep.y), "+v"(w.y));
                            u32x4 o4; o4.x = keep.x; o4.y = keep.y; o4.z = w.x; o4.w = w.y;
                            *(u32x4*)(ACT + (size_t)(row0 + ai * 128 + (fq < 2 ? m - 1 : m) * 16) * DFF + pn * 128 + wc * 32 + 16 * (fq & 1) + 8 * n) = o4;
                        }
                        __builtin_amdgcn_sched_barrier(0);
                    }
                }
            }
        } else {
#pragma unroll
            for (int ai = 0; ai < 2; ++ai)
#pragma unroll
                for (int m = 0; m < 4; ++m)
#pragma unroll
                    for (int bj = 0; bj < 2; ++bj) { f32x4 v0 = acc[ai][bj][m][0], v1 = acc[ai][bj][m][1]; const size_t o = (rowoff + row0 + ai * 128 + m * 16) * (size_t)ld + pn * 256 + bj * 128 + cw;
                        if (mode >= 2) { const u32x2 g = *(const u32x2*)((const unsigned char*)X1 + o); const float k = 1.f / 255.f;
                            v0 = v0 * ((f32x4){(float)(g.x & 255u), (float)((g.x >> 8) & 255u), (float)((g.x >> 16) & 255u), (float)(g.x >> 24)} * k); v1 = v1 * ((f32x4){(float)(g.y & 255u), (float)((g.y >> 8) & 255u), (float)((g.y >> 16) & 255u), (float)(g.y >> 24)} * k); }
                        if (mode == 3) { const u32x4 t = *(const u32x4*)(X2 + o); v0 = v0 + lo4(t); v1 = v1 + hi4(t); }
                        *(u32x4*)(O + o) = pack8v(v0, v1); }
        }
    }
};

__device__ __forceinline__ void transpose_item(const float* W, int K, int N, bf16* WT, LAS float* scr, int item, int lane, int permin) {
    const int nblk = N / 32, kb = item / nblk, nb = item % nblk, k0 = 64 * kb, n0 = 32 * nb;
    int ns = n0;
    if (permin == 1 && n0 < 1280) { const int p = n0 >> 8, w = n0 & 255; ns = 256 * p + 64 * ((w >> 5) & 3) + 32 * (w >> 7); }
    if (permin == 1 && n0 >= 2560 && n0 < 4608) { const int p = (n0 - 2560) >> 8, w = (n0 - 2560) & 255; ns = (w < 128) ? (2560 + 128 * p + w) : (3584 + 128 * p + (w - 128)); }
    if (permin == 2) { const int p = n0 >> 8, w = n0 & 255; ns = (w < 128) ? (128 * p + w) : (DFF + 128 * p + (w - 128)); }
    const int g8 = lane & 7, c4 = g8 * 4, s4 = (permin == 2) ? ((((g8 >> 1) & 1) << 4) | ((g8 & 1) << 3) | ((g8 >> 2) << 2)) : c4, kg = (lane >> 3) * 8; f32x4 v[8];
#pragma unroll
    for (int i = 0; i < 8; ++i) v[i] = *(const f32x4*)(W + (size_t)(k0 + kg + i) * N + ns + s4);
#pragma unroll
    for (int j = 0; j < 4; ++j) { u32x4 o; o.x = pk2(v[0][j], v[1][j]); o.y = pk2(v[2][j], v[3][j]); o.z = pk2(v[4][j], v[5][j]); o.w = pk2(v[6][j], v[7][j]);
        *(u32x4*)(WT + (size_t)(n0 + c4 + j) * K + k0 + kg) = o; }
    (void)scr;
}

__device__ __forceinline__ const float* xrow_ptr(const Params& p, int row) { return row < TP ? p.x_prompt + (size_t)row * D : p.x_sample + (size_t)(row - TP) * D; }
__device__ __forceinline__ int ada_idx(int row) { return row < TP ? 8 : ((row - TP) >> 11); }

__device__ __forceinline__ void phase_p0(const Params& p, LAS unsigned char* lds, int G, int wid_s) {
    int tid = wid_s * 64 + lane_id_(); asm volatile("" : "+v"(tid)); const int lane = tid & 63, wave = tid >> 6;
    float* ada = (float*)(p.ws + WS_ADA);
    {
        LAS float* sc = (LAS float*)lds;
        LAS float* part = (LAS float*)(lds + 40960);
        for (int item = blockIdx.x; item < 192; item += G) {
            for (int i = tid; i < 9 * 1024; i += NTHR) { const int v = i >> 10, k = i & 1023; const float cv = (v < 8) ? p.c[v * 1024 + k] : p.c_ctx[k]; sc[i] = cv * sigmoidf_(cv); }
            __syncthreads();
            const int n = item * 32 + (lane & 31), k0 = wave * 128 + (lane >> 5);
            float a0 = 0, a1 = 0, a2 = 0, a3 = 0, a4 = 0, a5 = 0, a6 = 0, a7 = 0, a8 = 0;
#pragma unroll 16
            for (int i = 0; i < 64; ++i) { const int k = k0 + 2 * i; const float w = p.w_ada[(size_t)k * 6144 + n];
                a0 += sc[k] * w; a1 += sc[1024 + k] * w; a2 += sc[2048 + k] * w; a3 += sc[3072 + k] * w; a4 += sc[4096 + k] * w; a5 += sc[5120 + k] * w; a6 += sc[6144 + k] * w; a7 += sc[7168 + k] * w; a8 += sc[8192 + k] * w; }
            LAS float* pw = part + wave * 9 * 64 + lane;
            pw[0] = a0; pw[64] = a1; pw[128] = a2; pw[192] = a3; pw[256] = a4; pw[320] = a5; pw[384] = a6; pw[448] = a7; pw[512] = a8;
            __syncthreads();
            for (int i = tid; i < 9 * 32; i += NTHR) { const int v = i >> 5, l = i & 31; float s = p.b_ada[item * 32 + l];
#pragma unroll
                for (int w = 0; w < 8; ++w) s += part[(w * 9 + v) * 64 + l] + part[(w * 9 + v) * 64 + 32 + l];
                ada[v * 6144 + item * 32 + l] = s; }
            __syncthreads();
        }
    }
    {
        LAS float* scr = (LAS float*)(lds + 65536 + wave * 8704);
        const int gw = blockIdx.x * 8 + wave, NGW = G * 8;
        constexpr int I_IN = 16 * (NIN / 32), I_SQ = 16 * 32, I_UP = 16 * (NUP / 32), I_DN = (DFF / 64) * 32;
        constexpr int NITEMS = I_IN + 3 * I_SQ + I_UP + I_DN;
        for (int it = gw; it < NITEMS; it += NGW) {
            int r = it;
            if (r < I_IN) { transpose_item(p.w_in, D, NIN, (bf16*)(p.ws + WS_WIN), scr, r, lane, 1); continue; } r -= I_IN;
            if (r < I_SQ) { transpose_item(p.w_att_out, D, D, (bf16*)(p.ws + WS_WATT), scr, r, lane, 0); continue; } r -= I_SQ;
            if (r < I_SQ) { transpose_item(p.w_conv_out, D, D, (bf16*)(p.ws + WS_WCONV), scr, r, lane, 0); continue; } r -= I_SQ;
            if (r < I_SQ) { transpose_item(p.w_o, D, D, (bf16*)(p.ws + WS_WO), scr, r, lane, 0); continue; } r -= I_SQ;
            if (r < I_UP) { transpose_item(p.w_up, D, NUP, (bf16*)(p.ws + WS_WUP), scr, r, lane, 2); continue; } r -= I_UP;
            transpose_item(p.w_down, DFF, D, (bf16*)(p.ws + WS_WDN), scr, r, lane, 0);
        }
    }
    if (blockIdx.x < 32) {
        __syncthreads();
        LAS float* red = (LAS float*)lds; const int b = blockIdx.x >> 2, kvh = blockIdx.x & 3;
        const f32x4* kr = (const f32x4*)(p.cache_k + ((size_t)(b * 512 + tid)) * KVW + kvh * 64); float ss = 0.f;
#pragma unroll
        for (int j = 0; j < 16; ++j) { const f32x4 v = kr[j]; ss += (v[0] * v[0] + v[1] * v[1]) + (v[2] * v[2] + v[3] * v[3]); }
        ss = wave_max(ss);
        if (lane == 0) red[wave] = ss;
        __syncthreads();
        if (tid == 0) { float mx = red[0];
#pragma unroll
            for (int w = 1; w < 8; ++w) mx = fmaxf(mx, red[w]);
            ((float*)(p.ws + WS_KMAX))[blockIdx.x] = sqrtf(mx); }
        __syncthreads();
    }
    {
        bf16* Ks = (bf16*)(p.ws + WS_KS); bf16* Vs = (bf16*)(p.ws + WS_VS);
        for (int i = blockIdx.x * NTHR + tid; i < 8 * 512 * 64; i += G * NTHR) {
            const int rowg = i >> 6, c4 = (i & 63) * 4, b = rowg >> 9, t = rowg & 511;
            const f32x4 kv = *(const f32x4*)(p.cache_k + (size_t)rowg * KVW + c4), vv = *(const f32x4*)(p.cache_v + (size_t)rowg * KVW + c4);
            u32x2 w; w.x = pk2(kv[0], kv[1]); w.y = pk2(kv[2], kv[3]); *(u32x2*)(Ks + ((size_t)b * LSAMP + t) * KVW + c4) = w;
            w.x = pk2(vv[0], vv[1]); w.y = pk2(vv[2], vv[3]); *(u32x2*)(Vs + ((size_t)b * LSAMP + t) * KVW + c4) = w;
        }
    }
}

__device__ __forceinline__ void mod_norm_store(const f32x4 (&v)[4], float rstd, const float* g, const float* sc, const float* sh, bf16* orow, int lane) {
#pragma unroll
    for (int j = 0; j < 4; ++j) { const int c = 256 * j + 4 * lane; const f32x4 gg = *(const f32x4*)(g + c), s1 = *(const f32x4*)(sc + c), s0 = *(const f32x4*)(sh + c);
        const f32x4 u = v[j] * rstd * gg * (s1 + 1.0f) + s0; u32x2 w; w.x = pk2(u[0], u[1]); w.y = pk2(u[2], u[3]); *(u32x2*)(orow + c) = w; }
}
__device__ __forceinline__ float sumsq4(const f32x4 (&v)[4]) { float s = 0.f;
#pragma unroll
    for (int j = 0; j < 4; ++j) s += (v[j][0] * v[j][0] + v[j][1] * v[j][1]) + (v[j][2] * v[j][2] + v[j][3] * v[j][3]);
    return wave_sum(s); }

__device__ __forceinline__ f32x4 ldp(const float* p) { return *(const f32x4*)p; }
__device__ __forceinline__ int rcol(int j, int lane) { return 512 * (j >> 1) + 8 * lane + 4 * (j & 1); }
__device__ __forceinline__ void ld_bf16_row(const bf16* r, int lane, f32x4 (&v)[4]) {
#pragma unroll
    for (int jj = 0; jj < 2; ++jj) { const u32x4 w = *(const u32x4*)(r + 512 * jj + 8 * lane); v[2 * jj] = (f32x4){bflo(w.x), bfhi(w.x), bflo(w.y), bfhi(w.y)}; v[2 * jj + 1] = (f32x4){bflo(w.z), bfhi(w.z), bflo(w.w), bfhi(w.w)}; } }
__device__ __forceinline__ void st_bf16_row(bf16* r, int lane, const f32x4 (&u)[4]) {
#pragma unroll
    for (int jj = 0; jj < 2; ++jj) { u32x4 w; w.x = pk2(u[2 * jj][0], u[2 * jj][1]); w.y = pk2(u[2 * jj][2], u[2 * jj][3]); w.z = pk2(u[2 * jj + 1][0], u[2 * jj + 1][1]); w.w = pk2(u[2 * jj + 1][2], u[2 * jj + 1][3]); *(u32x4*)(r + 512 * jj + 8 * lane) = w; } }
__device__ __forceinline__ void phase_u1(const Params& p, int G, int wid_s) {
    int tid = wid_s * 64 + lane_id_(); asm volatile("" : "+v"(tid)); const int lane = tid & 63, wave = tid >> 6, gw = blockIdx.x * 8 + wave, NGW = G * 8;
    const float* ada = (const float*)(p.ws + WS_ADA); bf16* U = (bf16*)(p.ws + WS_U);
    const int chunk = (T + NGW - 1) / NGW, rbeg = gw * chunk, rend = (rbeg + chunk < T) ? rbeg + chunk : T;
    int cur = -1; f32x4 gs[4], sh[4];
    for (int row = rbeg; row < rend; ++row) {
        const int idx = ada_idx(row);
        if (idx != cur) { cur = idx; const float* a = ada + idx * 6144;
#pragma unroll
            for (int j = 0; j < 4; ++j) { const int c = rcol(j, lane); gs[j] = ldp(p.g_pre1 + c) * (ldp(a + 1024 + c) + 1.0f); sh[j] = ldp(a + c); } }
        const float* xr = xrow_ptr(p, row); f32x4 v[4], u[4];
#pragma unroll
        for (int j = 0; j < 4; ++j) v[j] = ldp(xr + rcol(j, lane));
        const float rstd = rsqrtf(sumsq4(v) * (1.f / D) + EPS);
#pragma unroll
        for (int j = 0; j < 4; ++j) u[j] = v[j] * rstd * gs[j] + sh[j];
        st_bf16_row(U + (size_t)row * D, lane, u);
    }
}

__device__ __forceinline__ void phase_p6(const Params& p, int G, int wid_s) {
    int tid = wid_s * 64 + lane_id_(); asm volatile("" : "+v"(tid)); const int lane = tid & 63, wave = tid >> 6, gw = blockIdx.x * 8 + wave, NGW = G * 8;
    const float* ada = (const float*)(p.ws + WS_ADA); bf16* U = (bf16*)(p.ws + WS_U); const bf16* MO = (const bf16*)(p.ws + WS_MO);
    const int chunk = (T + NGW - 1) / NGW, rbeg = gw * chunk, rend = (rbeg + chunk < T) ? rbeg + chunk : T;
    int cur = -1; f32x4 q1[4], gs[4], sh[4];
    for (int row = rbeg; row < rend; ++row) {
        const int idx = ada_idx(row);
        if (idx != cur) { cur = idx; const float* a = ada + idx * 6144;
#pragma unroll
            for (int j = 0; j < 4; ++j) { const int c = rcol(j, lane); q1[j] = ldp(a + 2048 + c) * ldp(p.g_post1 + c); gs[j] = ldp(p.g_pre2 + c) * (ldp(a + 4096 + c) + 1.0f); sh[j] = ldp(a + 3072 + c); } }
        const float* xr = xrow_ptr(p, row); f32x4 v[4], h[4], u[4];
        ld_bf16_row(MO + (size_t)row * D, lane, v);
#pragma unroll
        for (int j = 0; j < 4; ++j) h[j] = ldp(xr + rcol(j, lane));
        const float rstd = rsqrtf(sumsq4(v) * (1.f / D) + EPS);
#pragma unroll
        for (int j = 0; j < 4; ++j) h[j] = h[j] + q1[j] * (v[j] * rstd);
        const float rstd2 = rsqrtf(sumsq4(h) * (1.f / D) + EPS);
#pragma unroll
        for (int j = 0; j < 4; ++j) u[j] = h[j] * rstd2 * gs[j] + sh[j];
        st_bf16_row(U + (size_t)row * D, lane, u);
    }
}
__device__ __forceinline__ void phase_p10(const Params& p, int G, int wid_s) {
    int tid = wid_s * 64 + lane_id_(); asm volatile("" : "+v"(tid)); const int lane = tid & 63, wave = tid >> 6, gw = blockIdx.x * 8 + wave, NGW = G * 8;
    const float* ada = (const float*)(p.ws + WS_ADA); const bf16* DN = (const bf16*)(p.ws + WS_U); const bf16* MO = (const bf16*)(p.ws + WS_MO);
    const int chunk = (T + NGW - 1) / NGW, rbeg = gw * chunk, rend = (rbeg + chunk < T) ? rbeg + chunk : T;
    int cur = -1; f32x4 q1[4], q2[4];
    for (int row = rbeg; row < rend; ++row) {
        const int idx = ada_idx(row);
        if (idx != cur) { cur = idx; const float* a = ada + idx * 6144;
#pragma unroll
            for (int j = 0; j < 4; ++j) { const int c = rcol(j, lane); q1[j] = ldp(a + 2048 + c) * ldp(p.g_post1 + c); q2[j] = ldp(a + 5120 + c) * ldp(p.g_post2 + c); } }
        const float* xr = xrow_ptr(p, row); f32x4 v[4], d[4], h[4];
        ld_bf16_row(MO + (size_t)row * D, lane, v); ld_bf16_row(DN + (size_t)row * D, lane, d);
#pragma unroll
        for (int j = 0; j < 4; ++j) h[j] = ldp(xr + rcol(j, lane));
        const float rstd1 = rsqrtf(sumsq4(v) * (1.f / D) + EPS), rstd2 = rsqrtf(sumsq4(d) * (1.f / D) + EPS);
#pragma unroll
        for (int j = 0; j < 4; ++j) *(f32x4*)(p.out + (size_t)row * D + rcol(j, lane)) = (h[j] + q1[j] * (v[j] * rstd1)) + q2[j] * (d[j] * rstd2);
    }
}

__device__ __forceinline__ void unpack8(const u32x4 w, float (&x)[8]) { x[0] = bflo(w.x); x[1] = bfhi(w.x); x[2] = bflo(w.y); x[3] = bfhi(w.y); x[4] = bflo(w.z); x[5] = bfhi(w.z); x[6] = bflo(w.w); x[7] = bfhi(w.w); }
__device__ __forceinline__ u32x4 pack8(const float (&x)[8]) { u32x4 w; w.x = pk2(x[0], x[1]); w.y = pk2(x[2], x[3]); w.z = pk2(x[4], x[5]); w.w = pk2(x[6], x[7]); return w; }

__device__ __forceinline__ void head_norm_rope(float (&x)[8], const float* gain, int e, bool rope, int t, const LAS float* tab) {
    float ss = 0.f;
#pragma unroll
    for (int j = 0; j < 8; ++j) ss += x[j] * x[j];
    ss += __shfl_xor(ss, 1); ss += __shfl_xor(ss, 2); ss += __shfl_xor(ss, 4);
    const float rstd = rsqrtf(ss * (1.f / 64.f) + EPS);
#pragma unroll
    for (int j = 0; j < 8; ++j) x[j] = x[j] * rstd * gain[e * 8 + j];
    float other[8];
#pragma unroll
    for (int j = 0; j < 8; ++j) other[j] = __shfl_xor(x[j], 2);
    if (rope) {
        const int pos = (e < 4) ? (t >> 6) : (t & 63); const LAS float* cs = tab + pos * 32 + 8 * (e & 1); const float sgn = (e & 2) ? 1.f : -1.f;
#pragma unroll
        for (int j = 0; j < 8; ++j) x[j] = x[j] * cs[j] + sgn * other[j] * cs[16 + j];
    }
}

__device__ __forceinline__ void phase_p2(const Params& p, LAS unsigned char* lds, int G, int wid_s) {
    int tid = wid_s * 64 + lane_id_(); asm volatile("" : "+v"(tid));
    const bf16* CX = (const bf16*)(p.ws + WS_CX); bf16* B = (bf16*)(p.ws + WS_B);
    float w0[8], w1[8], w2[8];
    { const int c0 = ((blockIdx.x * NTHR + tid) & 127) * 8;
#pragma unroll
      for (int j = 0; j < 8; ++j) { w0[j] = p.conv_w[c0 + j]; w1[j] = p.conv_w[D + c0 + j]; w2[j] = p.conv_w[2 * D + c0 + j]; } }
    for (int idx = blockIdx.x * NTHR + tid; idx < (T / 8) * 128; idx += G * NTHR) {
        const int tb = idx >> 7, cgp = idx & 127, row0 = tb * 8, c0 = cgp * 8;
        const int sbeg = row0 < TP ? (row0 & ~255) : (TP + ((row0 - TP) & ~2047)), send = sbeg + (row0 < TP ? 256 : 2048);
        u32x4 cr[10], br[8];
#pragma unroll
        for (int i = 0; i < 10; ++i) { int r = row0 - 1 + i; r = r < sbeg ? sbeg : (r >= send ? send - 1 : r); cr[i] = *(const u32x4*)(CX + (size_t)r * D + c0); }
#pragma unroll
        for (int i = 0; i < 8; ++i) br[i] = *(const u32x4*)(B + (size_t)(row0 + i) * D + c0);
        if (row0 == sbeg) cr[0] = (u32x4){0u, 0u, 0u, 0u};
        if (row0 + 8 == send) cr[9] = (u32x4){0u, 0u, 0u, 0u};
        float prev[8], cur[8], nxt[8];
        unpack8(cr[0], prev); unpack8(cr[1], cur);
#pragma unroll
        for (int i = 0; i < 8; ++i) {
            unpack8(cr[i + 2], nxt); float bb[8]; unpack8(br[i], bb);
#pragma unroll
            for (int j = 0; j < 8; ++j) { bb[j] *= (w0[j] * prev[j] + w1[j] * cur[j] + w2[j] * nxt[j]); prev[j] = cur[j]; cur[j] = nxt[j]; }
            *(u32x4*)(B + (size_t)(row0 + i) * D + c0) = pack8(bb);
        }
    }
}

__device__ __forceinline__ void phase_p8(const Params& p, int r0, int G, int wid_s) {
    int tid = wid_s * 64 + lane_id_(); asm volatile("" : "+v"(tid));
    const bf16* UP = (const bf16*)(p.ws + WS_UP); bf16* ACT = (bf16*)(p.ws + WS_ACT);
    constexpr int NCG = DFF / 8;
    for (int idx = blockIdx.x * NTHR + tid; idx < (CHUNK / 8) * NCG; idx += G * NTHR) {
        const int tb = idx / NCG, cgp = idx - tb * NCG, lrow0 = tb * 8, row0 = r0 + lrow0, c0 = cgp * 8;
        const int sbeg = row0 < TP ? (row0 & ~255) : (TP + ((row0 - TP) & ~2047)), send = sbeg + (row0 < TP ? 256 : 2048);
        u32x4 gr[10], vr[10];
#pragma unroll
        for (int i = 0; i < 10; ++i) { int r = row0 - 1 + i; r = r < sbeg ? sbeg : (r >= send ? send - 1 : r); const bf16* q = UP + (size_t)(r - r0) * NUP + c0; gr[i] = *(const u32x4*)q; vr[i] = *(const u32x4*)(q + DFF); }
        float wg0[8], wg1[8], wg2[8], wv0[8], wv1[8], wv2[8];
#pragma unroll
        for (int j = 0; j < 8; ++j) { wg0[j] = p.conv_ffn[c0 + j]; wg1[j] = p.conv_ffn[NUP + c0 + j]; wg2[j] = p.conv_ffn[2 * NUP + c0 + j];
            wv0[j] = p.conv_ffn[DFF + c0 + j]; wv1[j] = p.conv_ffn[NUP + DFF + c0 + j]; wv2[j] = p.conv_ffn[2 * NUP + DFF + c0 + j]; }
        if (row0 == sbeg) { gr[0] = (u32x4){0u, 0u, 0u, 0u}; vr[0] = gr[0]; }
        if (row0 + 8 == send) { gr[9] = (u32x4){0u, 0u, 0u, 0u}; vr[9] = gr[9]; }
        float gp[8], gc[8], gn[8], vp[8], vc[8], vn[8];
        unpack8(gr[0], gp); unpack8(gr[1], gc); unpack8(vr[0], vp); unpack8(vr[1], vc);
#pragma unroll
        for (int i = 0; i < 8; ++i) {
            unpack8(gr[i + 2], gn); unpack8(vr[i + 2], vn);
            float o[8];
#pragma unroll
            for (int j = 0; j < 8; ++j) { const float g = wg0[j] * gp[j] + wg1[j] * gc[j] + wg2[j] * gn[j], v = wv0[j] * vp[j] + wv1[j] * vc[j] + wv2[j] * vn[j];
                o[j] = g * sigmoidf_(g) * v; gp[j] = gc[j]; gc[j] = gn[j]; vp[j] = vc[j]; vc[j] = vn[j]; }
            *(u32x4*)(ACT + (size_t)(lrow0 + i) * DFF + c0) = pack8(o);
        }
    }
}

__device__ __forceinline__ void phase_fix(const Params& p, int G, int wid_s) {
    int tid = wid_s * 64 + lane_id_(); asm volatile("" : "+v"(tid));
    const float* HALO = (const float*)(p.ws + WS_HALO); bf16* ACT = (bf16*)(p.ws + WS_ACTF); const float* cf = p.conv_ffn;
    for (int idx = blockIdx.x * NTHR + tid; idx < 56 * (DFF / 4); idx += G * NTHR) {
        const int bnd = idx / (DFF / 4), j = (idx - bnd * (DFF / 4)) * 4, pm = 16 + (bnd / 7) * 8 + (bnd % 7);
        const float* L = HALO + (size_t)((pm * 2 + 1) * 4) * DFF + j; const float* F = HALO + (size_t)(((pm + 1) * 2 + 0) * 4) * DFF + j;
        const f32x4 Lpg = *(const f32x4*)L, Lpv = *(const f32x4*)(L + DFF), Lrg = *(const f32x4*)(L + 2 * DFF), Lrv = *(const f32x4*)(L + 3 * DFF);
        const f32x4 Fpg = *(const f32x4*)F, Fpv = *(const f32x4*)(F + DFF), Frg = *(const f32x4*)(F + 2 * DFF), Frv = *(const f32x4*)(F + 3 * DFF);
        const f32x4 wg0 = *(const f32x4*)(cf + j), wg2 = *(const f32x4*)(cf + 2 * NUP + j), wv0 = *(const f32x4*)(cf + DFF + j), wv2 = *(const f32x4*)(cf + 2 * NUP + DFF + j);
        const f32x4 gA = Lpg + wg2 * Frg, vA = Lpv + wv2 * Frv, gB = Fpg + wg0 * Lrg, vB = Fpv + wv0 * Lrv;
        const f32x4 aA = gA * sig4(gA) * vA, aB = gB * sig4(gB) * vB;
        u32x2 w; w.x = pk2(aA[0], aA[1]); w.y = pk2(aA[2], aA[3]); *(u32x2*)(ACT + (size_t)(pm * 256 + 255) * DFF + j) = w;
        w.x = pk2(aB[0], aB[1]); w.y = pk2(aB[2], aB[3]); *(u32x2*)(ACT + (size_t)((pm + 1) * 256) * DFF + j) = w;
    }
}

typedef short v4i16_t __attribute__((ext_vector_type(4)));
__device__ __forceinline__ s16x4 vtr(const LAS unsigned char* p) { return __builtin_bit_cast(s16x4, __builtin_amdgcn_ds_read_tr16_b64_v4i16((LAS v4i16_t*)p)); }
__device__ __forceinline__ bf16x8 pkfrag(float a, float b, float c, float d, float e, float f, float g, float h) {
    u32x4 w; w.x = pk2(a, b); w.y = pk2(c, d); w.z = pk2(e, f); w.w = pk2(g, h); return __builtin_bit_cast(bf16x8, w); }

__device__ __forceinline__ float max3f(float a, float b, float c) { float r; asm("v_max3_f32 %0, %1, %2, %3" : "=v"(r) : "v"(a), "v"(b), "v"(c)); return r; }
__device__ __forceinline__ void attn_unit(const bf16* Qg, bf16* Og, const bf16* Kg, const bf16* Vg, int L, int kvh, float kbound, LAS unsigned char* lds, int wid_s) {
    int tid = wid_s * 64 + lane_id_(); asm volatile("" : "+v"(tid)); const int lane = tid & 63, r32 = lane & 31, hi = lane >> 5, wid = __builtin_amdgcn_readfirstlane(tid >> 6);
    const int head = kvh * 4 + (wid >> 1), qrow0 = (wid & 1) * 32;
    const bf16* qp = Qg + (size_t)(qrow0 + r32) * D + head * 64 + hi * 8;
    bf16x8 qr[4];
#pragma unroll
    for (int d0 = 0; d0 < 4; ++d0) qr[d0] = *(const bf16x8*)(qp + d0 * 16);
    float qn2 = 0.f;
#pragma unroll
    for (int d0 = 0; d0 < 4; ++d0) { const u32x4 w = __builtin_bit_cast(u32x4, qr[d0]); const float a0 = bflo(w.x), a1 = bfhi(w.x), a2 = bflo(w.y), a3 = bfhi(w.y), a4 = bflo(w.z), a5 = bfhi(w.z), a6 = bflo(w.w), a7 = bfhi(w.w);
        qn2 += ((a0 * a0 + a1 * a1) + (a2 * a2 + a3 * a3)) + ((a4 * a4 + a5 * a5) + (a6 * a6 + a7 * a7)); }
    qn2 = lsum32(qn2);
    const float nm = -(sqrtf(qn2) * kbound);
    f32x16 negm;
#pragma unroll
    for (int r = 0; r < 16; ++r) negm[r] = nm;
    const int skey = tid >> 3, sch = tid & 7;
    const bf16* kg = Kg + (size_t)skey * KVW + kvh * 64 + sch * 8;
    const bf16* vg = Vg + (size_t)skey * KVW + kvh * 64 + sch * 8;
    const int kdst = (skey * 128 + ((sch ^ (skey & 7)) * 16)) ^ (((skey >> 3) & 1) << 7);
    const int vdst = 8192 + skey * 128 + (((sch >> 2) ^ ((skey >> 1) & 1)) * 64) + (sch & 3) * 16;
    const int NT = L >> 6;
    const int koff = r32 * 128, ksw = r32 & 7, kx = ((r32 >> 3) & 1) << 7;
    const int g4 = lane >> 4, i16 = lane & 15, q_ = i16 >> 2, p_ = i16 & 3;
    const int vb0 = 8192 + (4 * hi + q_) * 128 + ((q_ >> 1) * 64) + (16 * (g4 & 1) + 4 * p_) * 2, vb1 = vb0 ^ 64;
    f32x16 o0 = {}, o1 = {}, o2 = {}; unsigned one2 = 0x3F803F80u; asm volatile("" : "+v"(one2)); const bf16x8 ones = __builtin_bit_cast(bf16x8, (u32x4){one2, one2, one2, one2});
    auto qk = [&](const LAS unsigned char* kbuf, f32x16& s0, f32x16& s1) {
#pragma unroll
        for (int d0 = 0; d0 < 4; ++d0) { const int off = (koff + (((2 * d0 + hi) ^ ksw) * 16)) ^ kx;
            const bf16x8 a0 = *(const LAS bf16x8*)(kbuf + off), a1 = *(const LAS bf16x8*)(kbuf + off + 4096);
            s0 = __builtin_amdgcn_mfma_f32_32x32x16_bf16(a0, qr[d0], d0 == 0 ? negm : s0, 0, 0, 0); s1 = __builtin_amdgcn_mfma_f32_32x32x16_bf16(a1, qr[d0], d0 == 0 ? negm : s1, 0, 0, 0); }
    };
    u32x4 kA = *(const u32x4*)kg, vA = *(const u32x4*)vg, kB = *(const u32x4*)(kg + (size_t)64 * KVW);
    *(LAS u32x4*)(lds + kdst) = kA; *(LAS u32x4*)(lds + vdst) = vA; *(LAS u32x4*)(lds + 16384 + kdst) = kB;
    kA = *(const u32x4*)(kg + (size_t)2 * 64 * KVW); vA = *(const u32x4*)(vg + (size_t)1 * 64 * KVW);
    kB = *(const u32x4*)(kg + (size_t)3 * 64 * KVW); u32x4 vB = *(const u32x4*)(vg + (size_t)2 * 64 * KVW);
    __syncthreads();
    f32x16 s0, s1;
    qk(lds, s0, s1);
    LDS_WAIT();
    __syncthreads();
    auto tile = [&](int t, u32x4& kw, u32x4& vw) {
        const LAS unsigned char* vbuf = lds + (t & 1) * 16384; LAS unsigned char* obuf = lds + ((t + 1) & 1) * 16384;
        bf16x8 kf0[4], kf1[4]; s16x4 vl0[4], vh0[4], vl1[4], vh1[4];
#pragma unroll
        for (int d0 = 0; d0 < 4; ++d0) { const int off = (koff + (((2 * d0 + hi) ^ ksw) * 16)) ^ kx; kf0[d0] = *(const LAS bf16x8*)(obuf + off); kf1[d0] = *(const LAS bf16x8*)(obuf + off + 4096); }
#pragma unroll
        for (int ks = 0; ks < 4; ++ks) { vl0[ks] = vtr(vbuf + vb0 + ks * 2048); vh0[ks] = vtr(vbuf + vb0 + ks * 2048 + 1024); vl1[ks] = vtr(vbuf + vb1 + ks * 2048); vh1[ks] = vtr(vbuf + vb1 + ks * 2048 + 1024); }
        __builtin_amdgcn_sched_barrier(0);
        f32x16 n0, n1;
#pragma unroll
        for (int d0 = 0; d0 < 4; ++d0) { n0 = __builtin_amdgcn_mfma_f32_32x32x16_bf16(kf0[d0], qr[d0], d0 == 0 ? negm : n0, 0, 0, 0); n1 = __builtin_amdgcn_mfma_f32_32x32x16_bf16(kf1[d0], qr[d0], d0 == 0 ? negm : n1, 0, 0, 0); }
#pragma unroll
        for (int r = 0; r < 16; ++r) { s0[r] = fexp2(s0[r]); s1[r] = fexp2(s1[r]); }
        bf16x8 pb[4];
        pb[0] = pkfrag(s0[0], s0[1], s0[2], s0[3], s0[4], s0[5], s0[6], s0[7]); pb[1] = pkfrag(s0[8], s0[9], s0[10], s0[11], s0[12], s0[13], s0[14], s0[15]);
        pb[2] = pkfrag(s1[0], s1[1], s1[2], s1[3], s1[4], s1[5], s1[6], s1[7]); pb[3] = pkfrag(s1[8], s1[9], s1[10], s1[11], s1[12], s1[13], s1[14], s1[15]);
#pragma unroll
        for (int ks = 0; ks < 4; ++ks) {
            const bf16x8 a0 = (bf16x8){vl0[ks][0], vl0[ks][1], vl0[ks][2], vl0[ks][3], vh0[ks][0], vh0[ks][1], vh0[ks][2], vh0[ks][3]}, a1 = (bf16x8){vl1[ks][0], vl1[ks][1], vl1[ks][2], vl1[ks][3], vh1[ks][0], vh1[ks][1], vh1[ks][2], vh1[ks][3]};
            o0 = __builtin_amdgcn_mfma_f32_32x32x16_bf16(a0, pb[ks], o0, 0, 0, 0); o1 = __builtin_amdgcn_mfma_f32_32x32x16_bf16(a1, pb[ks], o1, 0, 0, 0);
            o2 = __builtin_amdgcn_mfma_f32_32x32x16_bf16(ones, pb[ks], o2, 0, 0, 0);
        }
        *(LAS u32x4*)(lds + (t & 1) * 16384 + kdst) = kw;
        *(LAS u32x4*)(obuf + vdst) = vw;
        { const int tk = (t + 4 < NT) ? t + 4 : NT - 1, tv = (t + 3 < NT) ? t + 3 : NT - 1;
          kw = *(const u32x4*)(kg + (size_t)tk * 64 * KVW); vw = *(const u32x4*)(vg + (size_t)tv * 64 * KVW); }
        __syncthreads();
        s0 = n0; s1 = n1;
    };
#pragma unroll 1
    for (int t = 0; t < NT; t += 2) { tile(t, kA, vA); tile(t + 1, kB, vB); }
    const float inv = 1.f / o2[0];
    LAS unsigned char* st = lds + wid * 4608;
#pragma unroll
    for (int g = 0; g < 4; ++g) { const int d = 8 * g + 4 * hi;
        u32x2 w; w.x = pk2(o0[4 * g] * inv, o0[4 * g + 1] * inv); w.y = pk2(o0[4 * g + 2] * inv, o0[4 * g + 3] * inv); *(LAS u32x2*)(st + r32 * 144 + d * 2) = w;
        w.x = pk2(o1[4 * g] * inv, o1[4 * g + 1] * inv); w.y = pk2(o1[4 * g + 2] * inv, o1[4 * g + 3] * inv); *(LAS u32x2*)(st + r32 * 144 + (32 + d) * 2) = w; }
    LDS_WAIT();
#pragma unroll
    for (int it = 0; it < 4; ++it) { const int id = it * 64 + lane, q = id >> 3, c = id & 7;
        const u32x4 v = *(const LAS u32x4*)(st + q * 144 + c * 16); *(u32x4*)(Og + (size_t)(qrow0 + q) * D + head * 64 + c * 8) = v; }
    __syncthreads();
}

__device__ __forceinline__ void phase_attn(const Params& p, LAS unsigned char* lds, int G, int wid_s) {
    const bf16* Q = (const bf16*)(p.ws + WS_Q); bf16* O = (bf16*)(p.ws + WS_U);
    const bf16 *Kp = (const bf16*)(p.ws + WS_KP), *Vp = (const bf16*)(p.ws + WS_VP), *Ks = (const bf16*)(p.ws + WS_KS), *Vs = (const bf16*)(p.ws + WS_VS);
    int tl = lane_id_(); asm volatile("" : "+v"(tl));
    float gk = fabsf(p.k_norm[tl & 63]);
    gk = wave_max(gk);
    const int klat_i = __builtin_amdgcn_readfirstlane(__builtin_bit_cast(int, 8.f * gk));
    const float* kmax = (const float*)(p.ws + WS_KMAX);
    const int vcu = (G % 8 == 0) ? ((int)(blockIdx.x % 8) * (G / 8) + (int)(blockIdx.x / 8)) : (int)blockIdx.x;
    for (int u = vcu; u < 1280; u += G) {
        int ki = __builtin_amdgcn_readfirstlane(klat_i); asm volatile("" : "+s"(ki)); const float klat = __builtin_bit_cast(float, ki);
        if (u < 1024) { const int b = u >> 7, kvh = (u >> 5) & 3, qb = u & 31; const size_t r = (size_t)(TP + b * 2048 + qb * 64) * D;
            attn_unit(Q + r, O + r, Ks + (size_t)b * LSAMP * KVW, Vs + (size_t)b * LSAMP * KVW, LSAMP, kvh, 1.01f * fmaxf(klat, kmax[b * 4 + kvh]), lds, wid_s); }
        else { const int v = u - 1024, s = v >> 4, kvh = (v >> 2) & 3, qb = v & 3; const size_t r = (size_t)(s * 256 + qb * 64) * D;
            attn_unit(Q + r, O + r, Kp + (size_t)s * 256 * KVW, Vp + (size_t)s * 256 * KVW, 256, kvh, 1.01f * klat, lds, wid_s); }
    }
}

struct WOrder : pg8::StaticOrder { int wid; };

#ifndef PROG_LIST
#define PROG_LIST 0,1,2,3,5,6,7,8,9,10,11,15
#endif
__constant__ unsigned char PROG[] = {PROG_LIST};
__global__ void __launch_bounds__(NTHR, 2) fwd_megakernel(Params p_arg) {
#if defined(__HIP_DEVICE_COMPILE__)
    extern __shared__ __attribute__((aligned(16))) unsigned char lds_raw[];
    LAS unsigned char* lds = (LAS unsigned char*)lds_raw;
    cg::grid_group grid = cg::this_grid();
    const int G = gridDim.x;
    volatile LAS unsigned* bst = (volatile LAS unsigned*)(lds + LDS_BYTES - 64);
    if (threadIdx.x < 16) bst[threadIdx.x] = 0u;
    { LAS float* tab = (LAS float*)(lds + 131072 + 8192);
      for (int i = threadIdx.x; i < 1024; i += NTHR) { const int pos = i >> 4, k = i & 15; const float ang = (float)pos * fexp2(-(float)k * (13.287712379549449f / 16.f)); tab[pos * 32 + k] = __cosf(ang); tab[pos * 32 + 16 + k] = __sinf(ang); } }
    __syncthreads();
    const int wid_s = __builtin_amdgcn_readfirstlane((int)(threadIdx.x >> 6));
    const XcdBarrier bar = xcd_barrier_post((unsigned*)(p_arg.ws + WS_BAR), bst, wid_s);
    constexpr int NSTEP = sizeof(PROG);
    { const Params p0 = p_arg; phase_p0(p0, lds, G, wid_s); }
    grid.sync();
#pragma unroll 1
    for (int pc = 1; pc < NSTEP; ++pc) {
        int step = __builtin_amdgcn_readfirstlane((int)PROG[pc]);
        asm volatile("" : "+s"(step));
        const __attribute__((address_space(4))) Params* kp = (const __attribute__((address_space(4))) Params*)__builtin_amdgcn_kernarg_segment_ptr();
        asm volatile("" : "+s"(kp));
        const Params p = *kp; unsigned char* ws = p.ws;
        const bf16* A = nullptr; const bf16* Bt = nullptr; int M = 0, N = 0, K = 0; bool is_gemm = true;
        EpiU e; e.mode = 1; e.ld = D; e.O = nullptr; e.rowoff = 0; e.X1 = nullptr; e.X2 = nullptr; e.xl = lds + 131072; e.kp = kp;
        bf16 *U = (bf16*)(ws + WS_U), *Q = (bf16*)(ws + WS_Q), *CX = (bf16*)(ws + WS_CX), *B = (bf16*)(ws + WS_B);
        switch (step) {
            case 1: phase_u1(p, G, wid_s); is_gemm = false; break;
            case 2: A = U; Bt = (const bf16*)(ws + WS_WIN); M = T; N = NIN; K = D; e.mode = 0; break;
            case 3: phase_p2(p, lds, G, wid_s); phase_attn(p, lds, G, wid_s); is_gemm = false; break;
            case 5: A = U; Bt = (const bf16*)(ws + WS_WATT); M = T; N = D; K = D; e.mode = 2; e.X1 = (const bf16*)p.out; e.O = CX; break;
            case 6: A = B; Bt = (const bf16*)(ws + WS_WCONV); M = T; N = D; K = D; e.mode = 3; e.X1 = (const bf16*)((const unsigned char*)p.out + (size_t)T * D); e.X2 = CX; e.O = Q; break;
            case 7: A = Q; Bt = (const bf16*)(ws + WS_WO); M = T; N = D; K = D; e.O = (bf16*)(ws + WS_MO); break;
            case 8: phase_p6(p, G, wid_s); is_gemm = false; break;
            case 9: A = U; Bt = (const bf16*)(ws + WS_WUP); M = T; N = NUP; K = D; e.mode = 5; break;
            case 10: phase_fix(p, G, wid_s); is_gemm = false; break;
            case 11: A = (const bf16*)(ws + WS_ACTF); Bt = (const bf16*)(ws + WS_WDN); M = T; N = D; K = DFF; e.O = U; break;
            case 15: phase_p10(p, G, wid_s); is_gemm = false; break;
            default: is_gemm = false; break;
        }
        if (is_gemm) { pg8::Gemm g{A, Bt, M, N, K}; WOrder S; S.init(M, N, G, (int)blockIdx.x); S.wid = wid_s; pg8::gemm_phase<EpiU, WOrder, true, true>(lds, g, S, e); }
        if (pc + 1 < NSTEP) xcd_barrier(bar);
    }
#endif
}

extern "C" void kernel_launch(void* const* d_in, const int* in_sizes, int n_in, void* d_out, int out_size, void* d_ws, size_t ws_size, hipStream_t stream) {
    static int grid_blocks = 0;
    if (!grid_blocks) {
        int dev = 0, cus = 0, per_cu = 0;
        hipGetDevice(&dev);
        hipDeviceGetAttribute(&cus, hipDeviceAttributeMultiprocessorCount, dev);
        hipFuncSetAttribute((const void*)fwd_megakernel, hipFuncAttributeMaxDynamicSharedMemorySize, LDS_BYTES);
        hipOccupancyMaxActiveBlocksPerMultiprocessor(&per_cu, (const void*)fwd_megakernel, NTHR, LDS_BYTES);
        if (per_cu < 1) per_cu = 1;
        grid_blocks = cus * per_cu;
        (void)hipGetLastError();
    }
    Params p{};
    const float** pp = (const float**)&p;
    for (int i = 0; i < 22; ++i) pp[i] = (const float*)d_in[i];
    p.out = (float*)d_out; p.ws = (unsigned char*)d_ws;
    (void)hipMemsetAsync((unsigned char*)d_ws + WS_BAR, 0, WS_BAR_BYTES, stream);
    void* args[] = {&p};
    hipError_t e = hipLaunchCooperativeKernel((const void*)fwd_megakernel, dim3(grid_blocks), dim3(NTHR), args, LDS_BYTES, stream);
    if (e != hipSuccess) fprintf(stderr, "cooperative launch failed: %s (grid %d)\n", hipGetErrorString(e), grid_blocks);
}
```

```cpp
#include <hip/hip_runtime.h>
#include <hip/hip_cooperative_groups.h>
#include <cstdio>
#include <cstdint>
namespace cg = cooperative_groups;
__device__ __forceinline__ int lane_id_() { unsigned m = ~0u; asm volatile("" : "+s"(m)); return (int)__builtin_amdgcn_mbcnt_hi(m, __builtin_amdgcn_mbcnt_lo(m, 0u)); }
template <int X> __device__ __forceinline__ float lx(float v) { return __builtin_bit_cast(float, __builtin_amdgcn_ds_swizzle(__builtin_bit_cast(int, v), (X << 10) | 0x1F)); }
__device__ __forceinline__ void swap32(float v, float& lo, float& hi) { float a = v, b = v; asm volatile("s_nop 1\n\tv_permlane32_swap_b32 %0, %1\n\ts_nop 1" : "+v"(a), "+v"(b)); lo = a; hi = b; }
__device__ __forceinline__ float lsum32(float v) { float lo, hi; swap32(v, lo, hi); return lo + hi; }
__device__ __forceinline__ float lmax32(float v) { float lo, hi; swap32(v, lo, hi); return fmaxf(lo, hi); }
__device__ __forceinline__ float lother32(float v, bool low_half) { float lo, hi; swap32(v, lo, hi); return low_half ? hi : lo; }
namespace pg8 {
#define PG8_LAS __attribute__((address_space(3)))
typedef unsigned short bf16_t;
typedef short bf16x8 __attribute__((ext_vector_type(8)));
typedef float f32x4 __attribute__((ext_vector_type(4)));
typedef unsigned u32x4 __attribute__((ext_vector_type(4)));
constexpr int BM = 256, BK = 64, HALF = 128, HTB = HALF * BK * 2  , STAGE_BYTES = 8 * HTB, NXCD = 8, WGM = 8;

__host__ __device__ __forceinline__ int lds_byte(int r, int c) { const int st = (r >> 4) * 2 + (c >> 5), rr = r & 15, cc = c & 31, ob = rr * 64 + cc * 2; return st * 1024 + (ob ^ (((ob >> 9) & 1) << 5)); }
__host__ __device__ __forceinline__ void stage_rc(int b, int& R, int& C) { const int st = b / 1024, sb = b % 1024, swz = sb ^ (((sb >> 9) & 1) << 5); R = (st >> 1) * 16 + swz / 64; C = (st & 1) * 32 + (swz % 64) / 2; }
__host__ __device__ __forceinline__ int perm32(int rho) { const int n = rho >> 4, i = rho & 15; return 8 * (i >> 2) + 4 * n + (i & 3); }

struct Unit { int pm, pn; };
struct Gemm { const bf16_t* A; const bf16_t* Bt; int M, N, K; };

struct StaticOrder {
    int nM, nN, nwg, G, c;
    __host__ __device__ void init(int M, int N, int G_, int c_) { nM = M / BM; nN = N / BM; nwg = nM * nN; G = G_; c = c_; }
    __host__ __device__ bool next(int i, Unit& u) const {
        const long L = (long)i * G + c; if (L >= nwg) return false;
        int wgid = (int)L; { const int q = nwg / NXCD, r = nwg % NXCD, xcd = wgid % NXCD, off = wgid / NXCD; wgid = (xcd < r ? xcd * (q + 1) : r * (q + 1) + (xcd - r) * q) + off; }
        const int nig = WGM * nN, gid = wgid / nig, fm = gid * WGM, gsz = (nM - fm) < WGM ? (nM - fm) : WGM;
        u.pm = fm + ((wgid % nig) % gsz); u.pn = (wgid % nig) / gsz; return true;
    }
    __device__ __forceinline__ void a_ready(const Unit&) const {}
    __device__ __forceinline__ void done(const Unit&) const {}
};

__device__ __forceinline__ unsigned cvt_pk_bf16(float lo, float hi) { unsigned r; asm volatile("v_cvt_pk_bf16_f32 %0, %1, %2" : "=v"(r) : "v"(lo), "v"(hi)); return r; }
typedef float f32x2 __attribute__((ext_vector_type(2)));
template <class Epi, class Sched, bool ALIGN_EPI = false, bool SP2 = false>
__device__ __forceinline__ void gemm_phase(PG8_LAS unsigned char* lds, const Gemm g, const Sched& S, const Epi& E) {
    int tid = S.wid * 64 + lane_id_(); asm volatile("" : "+v"(tid)); const int wid = __builtin_amdgcn_readfirstlane(tid >> 6), lane = tid & 63, wr = wid >> 2, wc = wid & 3, fr = lane & 15, fq = lane >> 4;
    const int K = g.K, nt = K / BK;
    unsigned voffA[2], voffB[2];
#pragma unroll
    for (int i = 0; i < 2; ++i) { int R, C; stage_rc(tid * 16 + i * 8192, R, C); const int Rb = Epi::PERM ? ((R & ~31) + perm32(R & 31)) : R;
        voffA[i] = (unsigned)(R * K + C) * 2u; voffB[i] = (unsigned)(Rb * K + C) * 2u; }
    const size_t kstep = (size_t)(BK * 2);
    const size_t hstep = (size_t)HALF * K * 2;
    const size_t tstep = 2 * hstep;
    const unsigned ldsw = (unsigned)wid * 1024u;
    const int aoff = lds_byte(wr * 64 + fr, fq * 8), boff = lds_byte(wc * 32 + fr, fq * 8);
#define PG8_SA(b, h) (((b) * 2 + (h)) * HTB)
#define PG8_SB(b, h) ((4 + (b) * 2 + (h)) * HTB)
#define PG8_STAGE(bufoff, gbase, voff) do { _Pragma("unroll") for (int _i = 0; _i < 2; ++_i) \
        __builtin_amdgcn_global_load_lds((const unsigned*)((const char*)(gbase) + (voff)[_i]), (PG8_LAS unsigned*)(lds + (bufoff) + ldsw + _i * 8192), 16, 0, 0); } while (0)
#define PG8_LDA(dst, b, h) do { _Pragma("unroll") for (int m = 0; m < 4; ++m) _Pragma("unroll") for (int k = 0; k < 2; ++k) dst[m][k] = *(const PG8_LAS bf16x8*)(lds + PG8_SA(b, h) + aoff + m * 2048 + k * 1024); } while (0)
#define PG8_LDB(dst, b, h) do { _Pragma("unroll") for (int n = 0; n < 2; ++n) _Pragma("unroll") for (int k = 0; k < 2; ++k) dst[n][k] = *(const PG8_LAS bf16x8*)(lds + PG8_SB(b, h) + boff + n * 2048 + k * 1024); } while (0)
#define PG8_MMA(ai, bj, At, Bt) do { __builtin_amdgcn_s_setprio(1); _Pragma("unroll") for (int m = 0; m < 4; ++m) _Pragma("unroll") for (int n = 0; n < 2; ++n) _Pragma("unroll") for (int k = 0; k < 2; ++k) \
        acc[ai][bj][m][n] = __builtin_amdgcn_mfma_f32_16x16x32_bf16(Bt[n][k], At[m][k], acc[ai][bj][m][n], 0, 0, 0); __builtin_amdgcn_s_setprio(0); } while (0)
#define PG8_WAIT_V(n) asm volatile("s_waitcnt vmcnt(" #n ")" ::: "memory")
#define PG8_WAIT_L(n) asm volatile("s_waitcnt lgkmcnt(" #n ")" ::: "memory")
#define PG8_BAR __builtin_amdgcn_s_barrier()
#define PG8_SCHED __builtin_amdgcn_sched_barrier(0)
    Unit cur, nxt; int ui = 0;
    if (!S.next(0, cur)) return;
    f32x4 acc[2][2][4][2];
#pragma unroll
    for (int a = 0; a < 2; ++a)
#pragma unroll
        for (int b = 0; b < 2; ++b)
#pragma unroll
            for (int m = 0; m < 4; ++m)
#pragma unroll
                for (int n = 0; n < 2; ++n) acc[a][b][m][n] = (f32x4){0.f, 0.f, 0.f, 0.f};
    bf16x8 At[4][2], B0[2][2], B1[2][2];
    const char* cA = (const char*)g.A + (size_t)cur.pm * tstep; const char* cB = (const char*)g.Bt + (size_t)cur.pn * tstep;
    S.a_ready(cur);
    if constexpr (SP2) {
        PG8_STAGE(PG8_SB(0, 0), cB, voffB); PG8_STAGE(PG8_SB(0, 1), cB + hstep, voffB); PG8_STAGE(PG8_SA(0, 0), cA, voffA); PG8_STAGE(PG8_SA(0, 1), cA + hstep, voffA);
        if (wr == 1) PG8_BAR;
        PG8_WAIT_V(2); PG8_BAR;
        PG8_STAGE(PG8_SB(1, 0), cB + kstep, voffB); PG8_STAGE(PG8_SA(1, 0), cA + kstep, voffA); PG8_STAGE(PG8_SB(1, 1), cB + hstep + kstep, voffB);
        PG8_WAIT_V(6); PG8_BAR;
    } else {
        PG8_STAGE(PG8_SB(0, 0), cB, voffB); PG8_STAGE(PG8_SA(0, 0), cA, voffA); PG8_STAGE(PG8_SB(0, 1), cB + hstep, voffB); PG8_STAGE(PG8_SA(0, 1), cA + hstep, voffA);
        if (wr == 1) PG8_BAR;
        PG8_WAIT_V(4); PG8_BAR;
        PG8_STAGE(PG8_SB(1, 0), cB + kstep, voffB); PG8_STAGE(PG8_SA(1, 0), cA + kstep, voffA); PG8_STAGE(PG8_SB(1, 1), cB + hstep + kstep, voffB);
        PG8_WAIT_V(6); PG8_BAR;
    }
    for (;;) {
        const bool has_next = S.next(ui + 1, nxt);
        const char* nA = has_next ? (const char*)g.A + (size_t)nxt.pm * tstep : cA; const char* nB = has_next ? (const char*)g.Bt + (size_t)nxt.pn * tstep : cB;
        for (int t = 0; t < nt; t += 2) {
            const bool last = (t == nt - 2);
            const char* a1 = cA + (size_t)(t + 1) * kstep;
            const char* a2 = last ? nA : cA + (size_t)(t + 2) * kstep; const char* b2 = last ? nB : cB + (size_t)(t + 2) * kstep;
            const char* a3 = a2 + kstep; const char* b3 = b2 + kstep;
            if (last && has_next) S.a_ready(nxt);
            if constexpr (SP2) {
            PG8_LDB(B0, 0, 0); PG8_LDB(B1, 0, 1); PG8_SCHED; PG8_LDA(At, 0, 0); PG8_STAGE(PG8_SA(1, 1), a1 + hstep, voffA);
            PG8_WAIT_V(8); PG8_WAIT_L(0); PG8_BAR; PG8_MMA(0, 0, At, B0); PG8_MMA(0, 1, At, B1); PG8_BAR; PG8_SCHED;
            PG8_LDA(At, 0, 1); PG8_STAGE(PG8_SB(0, 0), b2, voffB); PG8_STAGE(PG8_SB(0, 1), b2 + hstep, voffB); PG8_STAGE(PG8_SA(0, 0), a2, voffA);
            PG8_WAIT_V(8); PG8_WAIT_L(0); PG8_BAR; PG8_MMA(1, 0, At, B0); PG8_MMA(1, 1, At, B1); PG8_BAR; PG8_SCHED;
            PG8_LDB(B0, 1, 0); PG8_LDB(B1, 1, 1); PG8_SCHED; PG8_LDA(At, 1, 0); PG8_STAGE(PG8_SA(0, 1), a2 + hstep, voffA);
            PG8_WAIT_V(8); PG8_WAIT_L(0); PG8_BAR; PG8_MMA(0, 0, At, B0); PG8_MMA(0, 1, At, B1); PG8_BAR; PG8_SCHED;
            PG8_LDA(At, 1, 1); PG8_STAGE(PG8_SB(1, 0), b3, voffB); PG8_STAGE(PG8_SB(1, 1), b3 + hstep, voffB); PG8_STAGE(PG8_SA(1, 0), a3, voffA);
            PG8_WAIT_V(8); PG8_WAIT_L(0); PG8_BAR; PG8_MMA(1, 0, At, B0); PG8_MMA(1, 1, At, B1); PG8_BAR; PG8_SCHED;
            } else {
            PG8_LDB(B0, 0, 0); PG8_SCHED; PG8_LDA(At, 0, 0); PG8_STAGE(PG8_SA(1, 1), a1 + hstep, voffA);
            PG8_WAIT_L(8); PG8_BAR; PG8_WAIT_L(0); PG8_MMA(0, 0, At, B0); PG8_BAR; PG8_SCHED;
            PG8_LDB(B1, 0, 1); PG8_STAGE(PG8_SB(0, 0), b2, voffB);
            PG8_BAR; PG8_WAIT_L(0); PG8_MMA(0, 1, At, B1); PG8_BAR;
            PG8_LDA(At, 0, 1); PG8_STAGE(PG8_SA(0, 0), a2, voffA);
            PG8_BAR; PG8_WAIT_L(0); PG8_MMA(1, 0, At, B0); PG8_BAR; PG8_SCHED;
            PG8_STAGE(PG8_SB(0, 1), b2 + hstep, voffB);
            PG8_WAIT_V(6); PG8_BAR; PG8_MMA(1, 1, At, B1); PG8_BAR;
            PG8_LDB(B0, 1, 0); PG8_SCHED; PG8_LDA(At, 1, 0); PG8_STAGE(PG8_SA(0, 1), a2 + hstep, voffA);
            PG8_WAIT_L(8); PG8_BAR; PG8_WAIT_L(0); PG8_MMA(0, 0, At, B0); PG8_BAR; PG8_SCHED;
            PG8_LDB(B1, 1, 1); PG8_STAGE(PG8_SB(1, 0), b3, voffB);
            PG8_BAR; PG8_WAIT_L(0); PG8_MMA(0, 1, At, B1); PG8_BAR;
            PG8_LDA(At, 1, 1); PG8_STAGE(PG8_SA(1, 0), a3, voffA);
            PG8_BAR; PG8_WAIT_L(0); PG8_MMA(1, 0, At, B0); PG8_BAR; PG8_SCHED;
            PG8_STAGE(PG8_SB(1, 1), b3 + hstep, voffB);
            PG8_WAIT_V(6); PG8_BAR; PG8_MMA(1, 1, At, B1); PG8_BAR;
            }
        }
        if constexpr (ALIGN_EPI) { if (wr == 0) PG8_BAR; }
        if constexpr (!Epi::AFTER_DRAIN) { E(acc, cur, wr, wc, fr, fq); S.done(cur); }
        if (!has_next) break;
#pragma unroll
        for (int a = 0; a < 2; ++a)
#pragma unroll
            for (int b = 0; b < 2; ++b)
#pragma unroll
                for (int m = 0; m < 4; ++m)
#pragma unroll
                    for (int n = 0; n < 2; ++n) acc[a][b][m][n] = (f32x4){0.f, 0.f, 0.f, 0.f};
        cur = nxt; cA = nA; cB = nB; ++ui;
        if constexpr (ALIGN_EPI) { if (wr == 1) PG8_BAR; }
    }
    PG8_WAIT_V(0);
    if constexpr (!ALIGN_EPI) { if (wr == 0) PG8_BAR; }
    PG8_BAR;
    if constexpr (Epi::AFTER_DRAIN) { E.fused(acc, cur, wr, wc, fr, fq, lds, wid, lane); S.done(cur); }
#undef PG8_SA
#undef PG8_SB
#undef PG8_STAGE
#undef PG8_LDA
#undef PG8_LDB
#undef PG8_MMA
#undef PG8_WAIT_V
#undef PG8_WAIT_L
#undef PG8_BAR
#undef PG8_SCHED
}
}

#define LAS __attribute__((address_space(3)))
typedef unsigned short bf16;
typedef float f32x4 __attribute__((ext_vector_type(4)));
typedef float f32x16 __attribute__((ext_vector_type(16)));
typedef short bf16x8 __attribute__((ext_vector_type(8)));
typedef short s16x4 __attribute__((ext_vector_type(4)));
typedef unsigned u32x4 __attribute__((ext_vector_type(4)));
typedef unsigned u32x2 __attribute__((ext_vector_type(2)));

constexpr int NTHR = 512;
constexpr int TP = 4096, TS = 16384, T = 20480, D = 1024, NIN = 6656, NUP = 5632, DFF = 2816;
constexpr int LSAMP = 2560, KVW = 256;
constexpr float EPS = 1e-6f;
constexpr float C2 = 0.125f * 1.4426950408889634f;
constexpr size_t MiB = 1u << 20;
constexpr size_t WS_BAR = 65536, WS_BAR_BYTES = 16384;
constexpr size_t WS_KMAX = 1 * MiB + 256 * 1024;
constexpr size_t WS_ADA = 1 * MiB, WS_WIN = 2 * MiB, WS_WATT = 15 * MiB, WS_WCONV = 17 * MiB, WS_WO = 19 * MiB, WS_WUP = 21 * MiB, WS_WDN = 32 * MiB,
    WS_U = 38 * MiB, WS_Q = 78 * MiB, WS_CX = 118 * MiB, WS_B = 158 * MiB, WS_KP = 198 * MiB, WS_VP = 200 * MiB, WS_KS = 202 * MiB, WS_VS = 212 * MiB,
    WS_KRAW = 222 * MiB, WS_VRAW = 232 * MiB,
    WS_UP = 78 * MiB, WS_ACT = 188 * MiB,
    WS_ACTF = 78 * MiB, WS_HALO = 190 * MiB, WS_MO = 198 * MiB;
constexpr int CHUNK = 10240;
constexpr int LDS_BYTES = 148480;

typedef float f32x2_t __attribute__((ext_vector_type(2)));
typedef __bf16 bf16x2_t __attribute__((ext_vector_type(2)));
__device__ __forceinline__ unsigned pk2(float lo, float hi) { f32x2_t v = {lo, hi}; bf16x2_t b = __builtin_convertvector(v, bf16x2_t); return __builtin_bit_cast(unsigned, b); }
__device__ __forceinline__ float bflo(unsigned w) { return __builtin_bit_cast(float, w << 16); }
__device__ __forceinline__ float bfhi(unsigned w) { return __builtin_bit_cast(float, w & 0xffff0000u); }
__device__ __forceinline__ float fexp2(float x) { return __builtin_amdgcn_exp2f(x); }
__device__ __forceinline__ float sigmoidf_(float x) { return __builtin_amdgcn_rcpf(1.f + fexp2(-1.4426950408889634f * x)); }
__device__ __forceinline__ float wave_sum(float v) { v += lx<1>(v); v += lx<2>(v); v += lx<4>(v); v += lx<8>(v); v += lx<16>(v); return lsum32(v); }
__device__ __forceinline__ float wave_max(float v) { v = fmaxf(v, lx<1>(v)); v = fmaxf(v, lx<2>(v)); v = fmaxf(v, lx<4>(v)); v = fmaxf(v, lx<8>(v)); v = fmaxf(v, lx<16>(v)); return lmax32(v); }
#define LDS_WAIT() asm volatile("s_waitcnt lgkmcnt(0)" ::: "memory")
#define XB_TMO      128
#define XB_XCNT(j)  (256  + 64 * (j))
#define XB_XSUB(j)  (1280 + 64 * (j))
#define XB_XGEN(j)  (2304 + 64 * (j))
#define XB_TOP      3328
#define XB_TOPGEN   3392
#define XCD_BAR_WORDS 3456
#define XB_SPIN_CAP (1u << 18)

__device__ __forceinline__ unsigned xb_ld(unsigned* p)              { return __hip_atomic_load(p, __ATOMIC_RELAXED, __HIP_MEMORY_SCOPE_AGENT); }
__device__ __forceinline__ unsigned xb_add(unsigned* p, unsigned v) { return __hip_atomic_fetch_add(p, v, __ATOMIC_RELAXED, __HIP_MEMORY_SCOPE_AGENT); }
__device__ __forceinline__ unsigned xb_xcc_id() { return (unsigned)__builtin_amdgcn_s_getreg((3 << 11) | 20) & 0xFu; }
#define XB_SPIN(cond, bar) do { unsigned _sp = 0; while (cond) { __builtin_amdgcn_s_sleep(1); \
    if ((++_sp & 255u) == 0u) { if (xb_ld(&(bar)[XB_TMO])) break; if (_sp > XB_SPIN_CAP) { atomicAdd(&(bar)[XB_TMO], 1u); break; } } } } while (0)

struct XcdBarrier {
    int w;
    unsigned* bar; unsigned x;
    volatile LAS unsigned* st;
};

__device__ __forceinline__ XcdBarrier xcd_barrier_post(unsigned* bar, volatile LAS unsigned* st, int w) {
    XcdBarrier b; b.w = w; b.bar = bar; b.x = xb_xcc_id(); b.st = st;
    if (threadIdx.x == 0) (void)xb_add(&bar[XB_XCNT(b.x)], 1u);
    return b;
}
__device__ __forceinline__ void xcd_barrier_complete(unsigned* bar, unsigned x, unsigned& nloc, unsigned& nx) {
    const unsigned G = gridDim.x * gridDim.y * gridDim.z;
    unsigned sum, cnt, mine, sp = 0u;
    for (;;) {
        sum = 0u; cnt = 0u; mine = 0u;
#pragma unroll
        for (unsigned j = 0; j < 16; ++j) { const unsigned c = xb_ld(&bar[XB_XCNT(j)]); sum += c; cnt += (c > 0u) ? 1u : 0u; mine = (j == x) ? c : mine; }
        if (sum == G) break;
        __builtin_amdgcn_s_sleep(1);
        if ((++sp & 255u) == 0u) { if (xb_ld(&bar[XB_TMO])) break; if (sp > XB_SPIN_CAP) { atomicAdd(&bar[XB_TMO], 1u); break; } }
    }
    nloc = mine > 0u ? mine : 1u; nx = cnt > 0u ? cnt : 1u;
}

__device__ __forceinline__ void xcd_barrier(const XcdBarrier& b) {
    asm volatile("s_waitcnt vmcnt(0)" ::: "memory");
    __syncthreads();
    if (b.w == 0 && lane_id_() == 0) {
        unsigned* bar = b.bar;
        __builtin_amdgcn_s_waitcnt(0);
        unsigned nloc = b.st[0], nx = b.st[1];
        if (nloc == 0u) { xcd_barrier_complete(bar, b.x, nloc, nx); b.st[0] = nloc; b.st[1] = nx; }
        const unsigned old = xb_add(&bar[XB_XSUB(b.x)], 1u);
        const unsigned gen = old / nloc;
        if (old + 1u == (gen + 1u) * nloc) {
            __builtin_amdgcn_fence(__ATOMIC_RELEASE, "agent");
            asm volatile("s_waitcnt vmcnt(0)" ::: "memory");
            const unsigned og = xb_add(&bar[XB_TOP], 1u);
            const unsigned tg = og / nx;
            if (og + 1u == (tg + 1u) * nx) xb_add(&bar[XB_TOPGEN], 1u);
            else XB_SPIN(xb_ld(&bar[XB_TOPGEN]) == tg, bar);
            __builtin_amdgcn_fence(__ATOMIC_ACQUIRE, "agent");
            xb_add(&bar[XB_XGEN(b.x)], 1u);
            asm volatile("s_waitcnt vmcnt(0)" ::: "memory");
        } else {
            XB_SPIN(xb_ld(&bar[XB_XGEN(b.x)]) == gen, bar);
            __builtin_amdgcn_fence(__ATOMIC_ACQUIRE, "agent");
            asm volatile("s_waitcnt vmcnt(0)" ::: "memory");
        }
    }
    __syncthreads();
}

struct Params {
    const float *x_prompt, *x_sample, *cache_k, *cache_v, *c, *c_ctx, *w_ada, *b_ada, *g_pre1, *g_post1, *g_pre2, *g_post2, *w_in, *q_norm, *k_norm,
        *w_att_out, *conv_w, *w_conv_out, *w_o, *w_up, *conv_ffn, *w_down;
    float* out; unsigned char* ws;
};

__device__ __forceinline__ u32x4 pack8v(const f32x4 a, const f32x4 b) { u32x4 w; w.x = pk2(a[0], a[1]); w.y = pk2(a[2], a[3]); w.z = pk2(b[0], b[1]); w.w = pk2(b[2], b[3]); return w; }
__device__ __forceinline__ f32x4 sig4(const f32x4 v) { return (f32x4){sigmoidf_(v[0]), sigmoidf_(v[1]), sigmoidf_(v[2]), sigmoidf_(v[3])}; }
__device__ __forceinline__ f32x4 lo4(const u32x4 w) { return (f32x4){bflo(w.x), bfhi(w.x), bflo(w.y), bfhi(w.y)}; }
__device__ __forceinline__ f32x4 hi4(const u32x4 w) { return (f32x4){bflo(w.z), bfhi(w.z), bflo(w.w), bfhi(w.w)}; }
template <int CTRL> __device__ __forceinline__ float dppf(float old, float src) { return __builtin_bit_cast(float, __builtin_amdgcn_update_dpp(__builtin_bit_cast(int, old), __builtin_bit_cast(int, src), CTRL, 0xf, 0xf, false)); }
__device__ __forceinline__ f32x4 rowprev4(const f32x4 x, const f32x4 wrap) { return (f32x4){dppf<0x111>(wrap[0], x[0]), dppf<0x111>(wrap[1], x[1]), dppf<0x111>(wrap[2], x[2]), dppf<0x111>(wrap[3], x[3])}; }
__device__ __forceinline__ f32x4 rownext4(const f32x4 x, const f32x4 wrap) { return (f32x4){dppf<0x101>(wrap[0], x[0]), dppf<0x101>(wrap[1], x[1]), dppf<0x101>(wrap[2], x[2]), dppf<0x101>(wrap[3], x[3])}; }
__device__ __forceinline__ f32x4 ror1_4(const f32x4 x) { return (f32x4){dppf<0x121>(x[0], x[0]), dppf<0x121>(x[1], x[1]), dppf<0x121>(x[2], x[2]), dppf<0x121>(x[3], x[3])}; }
__device__ __forceinline__ f32x4 ror15_4(const f32x4 x) { return (f32x4){dppf<0x12F>(x[0], x[0]), dppf<0x12F>(x[1], x[1]), dppf<0x12F>(x[2], x[2]), dppf<0x12F>(x[3], x[3])}; }
struct EpiU {
    static constexpr bool PERM = true, AFTER_DRAIN = false;
    int mode, ld; bf16* O; size_t rowoff; const bf16 *X1, *X2; LAS unsigned char* xl; const __attribute__((address_space(4))) Params* kp;
    __device__ __forceinline__ void operator()(const f32x4 (&acc)[2][2][4][2], const pg8::Unit& u, int wr, int wc, int fr, int fq) const {
        const int pn = u.pn, row0 = u.pm * 256 + wr * 64 + fr, cw = wc * 32 + 8 * fq;
        unsigned char* const ws = kp->ws; float* const outp = kp->out; bf16* const GA = (bf16*)outp;
        if (mode == 0) {
            if (pn >= 10 && pn < 18) {
                bf16* CX = (bf16*)(ws + WS_CX);
#pragma unroll
                for (int ai = 0; ai < 2; ++ai)
#pragma unroll
                    for (int m = 0; m < 4; ++m)
                        *(u32x4*)(CX + (size_t)(row0 + ai * 128 + m * 16) * D + (pn - 10) * 128 + cw) = pack8v(acc[ai][0][m][0] * acc[ai][1][m][0], acc[ai][0][m][1] * acc[ai][1][m][1]);
            } else if (pn < 5) {
                const bool isq = pn < 4, samp = u.pm >= 16; const float* gn = isq ? kp->q_norm : kp->k_norm; const int hcol = (isq ? (4 * pn + wc) : wc) * 64 + 8 * fq;
                const LAS float* tab = (const LAS float*)(xl + 8192);
                const float sgn = fq < 2 ? -1.f : 1.f, qs = isq ? C2 : 1.f; const int kidx = 8 * (fq & 1);
#pragma unroll
                for (int ai = 0; ai < 2; ++ai)
#pragma unroll
                    for (int m = 0; m < 4; ++m) {
                        const int row = row0 + ai * 128 + m * 16;
                        f32x4 v00 = acc[ai][0][m][0], v01 = acc[ai][0][m][1], v10 = acc[ai][1][m][0], v11 = acc[ai][1][m][1];
                        const f32x4 sq = v00 * v00 + v01 * v01 + v10 * v10 + v11 * v11; float ss = (sq[0] + sq[1]) + (sq[2] + sq[3]);
                        ss += lx<16>(ss); ss = lsum32(ss);
                        const float rstd = rsqrtf(ss * (1.f / 64.f) + EPS);
                        v00 = v00 * rstd * *(const f32x4*)(gn + 8 * fq); v01 = v01 * rstd * *(const f32x4*)(gn + 8 * fq + 4); v10 = v10 * rstd * *(const f32x4*)(gn + 32 + 8 * fq); v11 = v11 * rstd * *(const f32x4*)(gn + 32 + 8 * fq + 4);
                        if (samp) {
                            const int t = (row - TP) & 2047;
                            { const LAS float* tr = tab + (t >> 6) * 32 + kidx; const f32x4 c0 = *(const LAS f32x4*)tr, c1 = *(const LAS f32x4*)(tr + 4), s0 = *(const LAS f32x4*)(tr + 16), s1 = *(const LAS f32x4*)(tr + 20);
                              f32x4 o0, o1;
#pragma unroll
                              for (int i = 0; i < 4; ++i) { o0[i] = lother32(v00[i], fq < 2); o1[i] = lother32(v01[i], fq < 2); }
                              v00 = v00 * c0 + (o0 * s0) * sgn; v01 = v01 * c1 + (o1 * s1) * sgn; }
                            __builtin_amdgcn_sched_barrier(0);
                            { const LAS float* tc = tab + (t & 63) * 32 + kidx; const f32x4 c0 = *(const LAS f32x4*)tc, c1 = *(const LAS f32x4*)(tc + 4), s0 = *(const LAS f32x4*)(tc + 16), s1 = *(const LAS f32x4*)(tc + 20);
                              f32x4 o0, o1;
#pragma unroll
                              for (int i = 0; i < 4; ++i) { o0[i] = lother32(v10[i], fq < 2); o1[i] = lother32(v11[i], fq < 2); }
                              v10 = v10 * c0 + (o0 * s0) * sgn; v11 = v11 * c1 + (o1 * s1) * sgn; }
                        }
                        if (isq) { bf16* q = (bf16*)(ws + WS_Q) + (size_t)row * D + hcol; *(u32x4*)q = pack8v(v00 * qs, v01 * qs); *(u32x4*)(q + 32) = pack8v(v10 * qs, v11 * qs); }
                        else if (!samp) { bf16* k = (bf16*)(ws + WS_KP) + (size_t)row * KVW + hcol; *(u32x4*)k = pack8v(v00, v01); *(u32x4*)(k + 32) = pack8v(v10, v11);
                            float* nk = outp + (size_t)T * D + (size_t)row * KVW + hcol; *(f32x4*)nk = v00; *(f32x4*)(nk + 4) = v01; *(f32x4*)(nk + 32) = v10; *(f32x4*)(nk + 36) = v11; }
                        else { const int b = (row - TP) >> 11, t = (row - TP) & 2047; bf16* k = (bf16*)(ws + WS_KS) + ((size_t)b * LSAMP + 512 + t) * KVW + hcol; *(u32x4*)k = pack8v(v00, v01); *(u32x4*)(k + 32) = pack8v(v10, v11); }
                        __builtin_amdgcn_sched_barrier(0);
                    }
            } else if (pn == 5) {
                const bool samp = u.pm >= 16;
#pragma unroll
                for (int ai = 0; ai < 2; ++ai)
#pragma unroll
                    for (int m = 0; m < 4; ++m)
#pragma unroll
                        for (int bj = 0; bj < 2; ++bj) { const int row = row0 + ai * 128 + m * 16, c = bj * 128 + cw; const f32x4 v0 = acc[ai][bj][m][0], v1 = acc[ai][bj][m][1];
                            if (!samp) { *(u32x4*)((bf16*)(ws + WS_VP) + (size_t)row * KVW + c) = pack8v(v0, v1); float* nv = outp + (size_t)T * D + (size_t)TP * KVW + (size_t)row * KVW + c; *(f32x4*)nv = v0; *(f32x4*)(nv + 4) = v1; }
                            else { const int b = (row - TP) >> 11, t = (row - TP) & 2047; *(u32x4*)((bf16*)(ws + WS_VS) + ((size_t)b * LSAMP + 512 + t) * KVW + c) = pack8v(v0, v1); } }
            } else {
                if (pn >= 18) {
                    unsigned char* G8 = (unsigned char*)outp + (pn >= 22 ? (size_t)T * D : 0); const int cb = (pn >= 22 ? pn - 22 : pn - 18) * 256;
#pragma unroll
                    for (int ai = 0; ai < 2; ++ai)
#pragma unroll
                        for (int m = 0; m < 4; ++m)
#pragma unroll
                            for (int bj = 0; bj < 2; ++bj) { const f32x4 v0 = sig4(acc[ai][bj][m][0]) * 255.f + 0.5f, v1 = sig4(acc[ai][bj][m][1]) * 255.f + 0.5f;
                                u32x2 w; w.x = (unsigned)v0[0] | ((unsigned)v0[1] << 8) | ((unsigned)v0[2] << 16) | ((unsigned)v0[3] << 24); w.y = (unsigned)v1[0] | ((unsigned)v1[1] << 8) | ((unsigned)v1[2] << 16) | ((unsigned)v1[3] << 24);
                                *(u32x2*)(G8 + (size_t)(row0 + ai * 128 + m * 16) * D + cb + bj * 128 + cw) = w; }
                } else {
                    bf16* Op = (bf16*)(ws + WS_B); const int cb = (pn - 6) * 256;
#pragma unroll
                    for (int ai = 0; ai < 2; ++ai)
#pragma unroll
                        for (int m = 0; m < 4; ++m)
#pragma unroll
                            for (int bj = 0; bj < 2; ++bj) *(u32x4*)(Op + (size_t)(row0 + ai * 128 + m * 16) * D + cb + bj * 128 + cw) = pack8v(acc[ai][bj][m][0], acc[ai][bj][m][1]);
                }
            }
        } else if (mode == 5) {
            LAS float* XCH = (LAS float*)xl;
            const int colw = wc * 32 + 8 * fq;
            if (fr == 0) {
#pragma unroll
                for (int ai = 0; ai < 2; ++ai)
#pragma unroll
                    for (int bj = 0; bj < 2; ++bj)
#pragma unroll
                        for (int n = 0; n < 2; ++n) *(LAS f32x4*)(XCH + ((2 * ai + wr) * 2 + 0) * 256 + bj * 128 + colw + 4 * n) = acc[ai][bj][0][n];
            }
            if (fr == 15) {
#pragma unroll
                for (int ai = 0; ai < 2; ++ai)
#pragma unroll
                    for (int bj = 0; bj < 2; ++bj)
#pragma unroll
                        for (int n = 0; n < 2; ++n) *(LAS f32x4*)(XCH + ((2 * ai + wr) * 2 + 1) * 256 + bj * 128 + colw + 4 * n) = acc[ai][bj][3][n];
            }
            LDS_WAIT(); __builtin_amdgcn_s_barrier(); asm volatile("" ::: "memory");
            bf16* ACT = (bf16*)(ws + WS_ACTF); float* HALO = (float*)(ws + WS_HALO); const float* cf = kp->conv_ffn;
            const int jc = pn * 128 + wc * 32 + 16 * (fq & 1) + 4 * (fq >> 1);
#pragma unroll
            for (int n = 0; n < 2; ++n) {
                const f32x4 wg0 = *(const f32x4*)(cf + jc + 8 * n), wg1 = *(const f32x4*)(cf + NUP + jc + 8 * n), wg2 = *(const f32x4*)(cf + 2 * NUP + jc + 8 * n);
                const f32x4 wv0 = *(const f32x4*)(cf + DFF + jc + 8 * n), wv1 = *(const f32x4*)(cf + NUP + DFF + jc + 8 * n), wv2 = *(const f32x4*)(cf + 2 * NUP + DFF + jc + 8 * n);
#pragma unroll
                for (int ai = 0; ai < 2; ++ai) {
                    const int seg = 2 * ai + wr;
                    u32x2 keep;
#pragma unroll
                    for (int m = 0; m < 4; ++m) {
                        const f32x4 z4 = {0.f, 0.f, 0.f, 0.f};
                        const f32x4 xg = acc[ai][0][m][n];
                        f32x4 wp = z4, wn = z4;
                        if (m == 0) { if (seg > 0) wp = *(const LAS f32x4*)(XCH + ((seg - 1) * 2 + 1) * 256 + colw + 4 * n); } else wp = ror1_4(acc[ai][0][m == 0 ? 0 : m - 1][n]);
                        if (m == 3) { if (seg < 3) wn = *(const LAS f32x4*)(XCH + ((seg + 1) * 2 + 0) * 256 + colw + 4 * n); } else wn = ror15_4(acc[ai][0][m == 3 ? 3 : m + 1][n]);
                        const f32x4 cg = wg0 * rowprev4(xg, wp) + wg1 * xg + wg2 * rownext4(xg, wn);
                        __builtin_amdgcn_sched_barrier(0);
                        const f32x4 xv = acc[ai][1][m][n];
                        wp = z4; wn = z4;
                        if (m == 0) { if (seg > 0) wp = *(const LAS f32x4*)(XCH + ((seg - 1) * 2 + 1) * 256 + 128 + colw + 4 * n); } else wp = ror1_4(acc[ai][1][m == 0 ? 0 : m - 1][n]);
                        if (m == 3) { if (seg < 3) wn = *(const LAS f32x4*)(XCH + ((seg + 1) * 2 + 0) * 256 + 128 + colw + 4 * n); } else wn = ror15_4(acc[ai][1][m == 3 ? 3 : m + 1][n]);
                        const f32x4 cv = wv0 * rowprev4(xv, wp) + wv1 * xv + wv2 * rownext4(xv, wn);
                        if (seg == 0 && m == 0 && fr == 0) { float* h = HALO + (size_t)((u.pm * 2 + 0) * 4) * DFF + jc + 8 * n; *(f32x4*)h = cg; *(f32x4*)(h + DFF) = cv; *(f32x4*)(h + 2 * DFF) = xg; *(f32x4*)(h + 3 * DFF) = xv; }
                        if (seg == 3 && m == 3 && fr == 15) { float* h = HALO + (size_t)((u.pm * 2 + 1) * 4) * DFF + jc + 8 * n; *(f32x4*)h = cg; *(f32x4*)(h + DFF) = cv; *(f32x4*)(h + 2 * DFF) = xg; *(f32x4*)(h + 3 * DFF) = xv; }
                        const f32x4 a = cg * sig4(cg) * cv;
                        u32x2 w; w.x = pk2(a[0], a[1]); w.y = pk2(a[2], a[3]);
                        if ((m & 1) == 0) keep = w;
                        else {
                            asm volatile("s_nop 1\n\tv_permlane32_swap_b32 %0, %1\n\ts_nop 1" : "+v"(keep.x), "+v"(w.x));
                            asm volatile("s_nop 1\n\tv_permlane32_swap_b32 %0, %1\n\ts_nop 1" : "+v"(keep.y), "+v"(w.y));
                            u32x4 o4; o4.x = keep.x; o4.y = keep.y; o4.z = w.x; o4.w = w.y;
                            *(u32x4*)(ACT + (size_t)(row0 + ai * 128 + (fq < 2 ? m - 1 : m) * 16) * DFF + pn * 128 + wc * 32 + 16 * (fq & 1) + 8 * n) = o4;
                        }
                        __builtin_amdgcn_sched_barrier(0);
                    }
                }
            }
        } else {
#pragma unroll
            for (int ai = 0; ai < 2; ++ai)
#pragma unroll
                for (int m = 0; m < 4; ++m)
#pragma unroll
                    for (int bj = 0; bj < 2; ++bj) { f32x4 v0 = acc[ai][bj][m][0], v1 = acc[ai][bj][m][1]; const size_t o = (rowoff + row0 + ai * 128 + m * 16) * (size_t)ld + pn * 256 + bj * 128 + cw;
                        if (mode >= 2) { const u32x2 g = *(const u32x2*)((const unsigned char*)X1 + o); const float k = 1.f / 255.f;
                            v0 = v0 * ((f32x4){(float)(g.x & 255u), (float)((g.x >> 8) & 255u), (float)((g.x >> 16) & 255u), (float)(g.x >> 24)} * k); v1 = v1 * ((f32x4){(float)(g.y & 255u), (float)((g.y >> 8) & 255u), (float)((g.y >> 16) & 255u), (float)(g.y >> 24)} * k); }
                        if (mode == 3) { const u32x4 t = *(const u32x4*)(X2 + o); v0 = v0 + lo4(t); v1 = v1 + hi4(t); }
                        *(u32x4*)(O + o) = pack8v(v0, v1); }
        }
    }
};

__device__ __forceinline__ void transpose_item(const float* W, int K, int N, bf16* WT, LAS float* scr, int item, int lane, int permin) {
    const int nblk = N / 32, kb = item / nblk, nb = item % nblk, k0 = 64 * kb, n0 = 32 * nb;
    int ns = n0;
    if (permin == 1 && n0 < 1280) { const int p = n0 >> 8, w = n0 & 255; ns = 256 * p + 64 * ((w >> 5) & 3) + 32 * (w >> 7); }
    if (permin == 1 && n0 >= 2560 && n0 < 4608) { const int p = (n0 - 2560) >> 8, w = (n0 - 2560) & 255; ns = (w < 128) ? (2560 + 128 * p + w) : (3584 + 128 * p + (w - 128)); }
    int pl = lane & 31;
    if (permin == 2) { const int p = n0 >> 8, w = n0 & 255; ns = (w < 128) ? (128 * p + w) : (DFF + 128 * p + (w - 128));
        const int l = lane & 31, fq_ = l >> 3, n_ = (l >> 2) & 1; pl = ((fq_ & 1) << 4) | (n_ << 3) | ((fq_ >> 1) << 2) | (l & 3); }
    {
        const int g8 = lane & 7, c4 = g8 * 4, s4 = (permin == 2) ? ((((g8 >> 1) & 1) << 4) | ((g8 & 1) << 3) | ((g8 >> 2) << 2)) : c4, kr = lane >> 3; f32x4 v[8];
#pragma unroll
        for (int i = 0; i < 8; ++i) v[i] = *(const f32x4*)(W + (size_t)(k0 + 8 * i + kr) * N + ns + s4);
#pragma unroll
        for (int i = 0; i < 8; ++i) { LAS float* d = scr + (8 * i + kr) * 33 + c4; d[0] = v[i][0]; d[1] = v[i][1]; d[2] = v[i][2]; d[3] = v[i][3]; }
    }
    LDS_WAIT();
    const int c = lane & 7;
#pragma unroll
    for (int j = 0; j < 4; ++j) { const int n = (lane >> 3) + 8 * j; const LAS float* s = scr + (8 * c) * 33 + n;
        u32x4 o; o.x = pk2(s[0 * 33], s[1 * 33]); o.y = pk2(s[2 * 33], s[3 * 33]); o.z = pk2(s[4 * 33], s[5 * 33]); o.w = pk2(s[6 * 33], s[7 * 33]);
        *(u32x4*)(WT + (size_t)(n0 + n) * K + k0 + 8 * c) = o; }
    LDS_WAIT();
}

__device__ __forceinline__ const float* xrow_ptr(const Params& p, int row) { return row < TP ? p.x_prompt + (size_t)row * D : p.x_sample + (size_t)(row - TP) * D; }
__device__ __forceinline__ int ada_idx(int row) { return row < TP ? 8 : ((row - TP) >> 11); }

__device__ __forceinline__ void phase_p0(const Params& p, LAS unsigned char* lds, int G, int wid_s) {
    int tid = wid_s * 64 + lane_id_(); asm volatile("" : "+v"(tid)); const int lane = tid & 63, wave = tid >> 6;
    float* ada = (float*)(p.ws + WS_ADA);
    {
        LAS float* sc = (LAS float*)lds;
        LAS float* part = (LAS float*)(lds + 40960);
        for (int item = blockIdx.x; item < 192; item += G) {
            for (int i = tid; i < 9 * 1024; i += NTHR) { const int v = i >> 10, k = i & 1023; const float cv = (v < 8) ? p.c[v * 1024 + k] : p.c_ctx[k]; sc[i] = cv * sigmoidf_(cv); }
            __syncthreads();
            const int n = item * 32 + (lane & 31), k0 = wave * 128 + (lane >> 5);
            float a0 = 0, a1 = 0, a2 = 0, a3 = 0, a4 = 0, a5 = 0, a6 = 0, a7 = 0, a8 = 0;
#pragma unroll 16
            for (int i = 0; i < 64; ++i) { const int k = k0 + 2 * i; const float w = p.w_ada[(size_t)k * 6144 + n];
                a0 += sc[k] * w; a1 += sc[1024 + k] * w; a2 += sc[2048 + k] * w; a3 += sc[3072 + k] * w; a4 += sc[4096 + k] * w; a5 += sc[5120 + k] * w; a6 += sc[6144 + k] * w; a7 += sc[7168 + k] * w; a8 += sc[8192 + k] * w; }
            LAS float* pw = part + wave * 9 * 64 + lane;
            pw[0] = a0; pw[64] = a1; pw[128] = a2; pw[192] = a3; pw[256] = a4; pw[320] = a5; pw[384] = a6; pw[448] = a7; pw[512] = a8;
            __syncthreads();
            for (int i = tid; i < 9 * 32; i += NTHR) { const int v = i >> 5, l = i & 31; float s = p.b_ada[item * 32 + l];
#pragma unroll
                for (int w = 0; w < 8; ++w) s += part[(w * 9 + v) * 64 + l] + part[(w * 9 + v) * 64 + 32 + l];
                ada[v * 6144 + item * 32 + l] = s; }
            __syncthreads();
        }
    }
    {
        LAS float* scr = (LAS float*)(lds + 65536 + wave * 8704);
        const int gw = blockIdx.x * 8 + wave, NGW = G * 8;
        constexpr int I_IN = 16 * (NIN / 32), I_SQ = 16 * 32, I_UP = 16 * (NUP / 32), I_DN = (DFF / 64) * 32;
        constexpr int NITEMS = I_IN + 3 * I_SQ + I_UP + I_DN;
        for (int it = gw; it < NITEMS; it += NGW) {
            int r = it;
            if (r < I_IN) { transpose_item(p.w_in, D, NIN, (bf16*)(p.ws + WS_WIN), scr, r, lane, 1); continue; } r -= I_IN;
            if (r < I_SQ) { transpose_item(p.w_att_out, D, D, (bf16*)(p.ws + WS_WATT), scr, r, lane, 0); continue; } r -= I_SQ;
            if (r < I_SQ) { transpose_item(p.w_conv_out, D, D, (bf16*)(p.ws + WS_WCONV), scr, r, lane, 0); continue; } r -= I_SQ;
            if (r < I_SQ) { transpose_item(p.w_o, D, D, (bf16*)(p.ws + WS_WO), scr, r, lane, 0); continue; } r -= I_SQ;
            if (r < I_UP) { transpose_item(p.w_up, D, NUP, (bf16*)(p.ws + WS_WUP), scr, r, lane, 2); continue; } r -= I_UP;
            transpose_item(p.w_down, DFF, D, (bf16*)(p.ws + WS_WDN), scr, r, lane, 0);
        }
    }
    if (blockIdx.x < 32) {
        __syncthreads();
        LAS float* red = (LAS float*)lds; const int b = blockIdx.x >> 2, kvh = blockIdx.x & 3;
        const f32x4* kr = (const f32x4*)(p.cache_k + ((size_t)(b * 512 + tid)) * KVW + kvh * 64); float ss = 0.f;
#pragma unroll
        for (int j = 0; j < 16; ++j) { const f32x4 v = kr[j]; ss += (v[0] * v[0] + v[1] * v[1]) + (v[2] * v[2] + v[3] * v[3]); }
        ss = wave_max(ss);
        if (lane == 0) red[wave] = ss;
        __syncthreads();
        if (tid == 0) { float mx = red[0];
#pragma unroll
            for (int w = 1; w < 8; ++w) mx = fmaxf(mx, red[w]);
            ((float*)(p.ws + WS_KMAX))[blockIdx.x] = sqrtf(mx); }
        __syncthreads();
    }
    {
        bf16* Ks = (bf16*)(p.ws + WS_KS); bf16* Vs = (bf16*)(p.ws + WS_VS);
        for (int i = blockIdx.x * NTHR + tid; i < 8 * 512 * 64; i += G * NTHR) {
            const int rowg = i >> 6, c4 = (i & 63) * 4, b = rowg >> 9, t = rowg & 511;
            const f32x4 kv = *(const f32x4*)(p.cache_k + (size_t)rowg * KVW + c4), vv = *(const f32x4*)(p.cache_v + (size_t)rowg * KVW + c4);
            u32x2 w; w.x = pk2(kv[0], kv[1]); w.y = pk2(kv[2], kv[3]); *(u32x2*)(Ks + ((size_t)b * LSAMP + t) * KVW + c4) = w;
            w.x = pk2(vv[0], vv[1]); w.y = pk2(vv[2], vv[3]); *(u32x2*)(Vs + ((size_t)b * LSAMP + t) * KVW + c4) = w;
        }
    }
}

__device__ __forceinline__ void mod_norm_store(const f32x4 (&v)[4], float rstd, const float* g, const float* sc, const float* sh, bf16* orow, int lane) {
#pragma unroll
    for (int j = 0; j < 4; ++j) { const int c = 256 * j + 4 * lane; const f32x4 gg = *(const f32x4*)(g + c), s1 = *(const f32x4*)(sc + c), s0 = *(const f32x4*)(sh + c);
        const f32x4 u = v[j] * rstd * gg * (s1 + 1.0f) + s0; u32x2 w; w.x = pk2(u[0], u[1]); w.y = pk2(u[2], u[3]); *(u32x2*)(orow + c) = w; }
}
__device__ __forceinline__ float sumsq4(const f32x4 (&v)[4]) { float s = 0.f;
#pragma unroll
    for (int j = 0; j < 4; ++j) s += (v[j][0] * v[j][0] + v[j][1] * v[j][1]) + (v[j][2] * v[j][2] + v[j][3] * v[j][3]);
    return wave_sum(s); }

__device__ __forceinline__ f32x4 ldp(const float* p) { return *(const f32x4*)p; }
__device__ __forceinline__ int rcol(int j, int lane) { return 512 * (j >> 1) + 8 * lane + 4 * (j & 1); }
__device__ __forceinline__ void ld_bf16_row(const bf16* r, int lane, f32x4 (&v)[4]) {
#pragma unroll
    for (int jj = 0; jj < 2; ++jj) { const u32x4 w = *(const u32x4*)(r + 512 * jj + 8 * lane); v[2 * jj] = (f32x4){bflo(w.x), bfhi(w.x), bflo(w.y), bfhi(w.y)}; v[2 * jj + 1] = (f32x4){bflo(w.z), bfhi(w.z), bflo(w.w), bfhi(w.w)}; } }
__device__ __forceinline__ void st_bf16_row(bf16* r, int lane, const f32x4 (&u)[4]) {
#pragma unroll
    for (int jj = 0; jj < 2; ++jj) { u32x4 w; w.x = pk2(u[2 * jj][0], u[2 * jj][1]); w.y = pk2(u[2 * jj][2], u[2 * jj][3]); w.z = pk2(u[2 * jj + 1][0], u[2 * jj + 1][1]); w.w = pk2(u[2 * jj + 1][2], u[2 * jj + 1][3]); *(u32x4*)(r + 512 * jj + 8 * lane) = w; } }
__device__ __forceinline__ void phase_u1(const Params& p, int G, int wid_s) {
    int tid = wid_s * 64 + lane_id_(); asm volatile("" : "+v"(tid)); const int lane = tid & 63, wave = tid >> 6, gw = blockIdx.x * 8 + wave, NGW = G * 8;
    const float* ada = (const float*)(p.ws + WS_ADA); bf16* U = (bf16*)(p.ws + WS_U);
    const int chunk = (T + NGW - 1) / NGW, rbeg = gw * chunk, rend = (rbeg + chunk < T) ? rbeg + chunk : T;
    int cur = -1; f32x4 gs[4], sh[4];
    for (int row = rbeg; row < rend; ++row) {
        const int idx = ada_idx(row);
        if (idx != cur) { cur = idx; const float* a = ada + idx * 6144;
#pragma unroll
            for (int j = 0; j < 4; ++j) { const int c = rcol(j, lane); gs[j] = ldp(p.g_pre1 + c) * (ldp(a + 1024 + c) + 1.0f); sh[j] = ldp(a + c); } }
        const float* xr = xrow_ptr(p, row); f32x4 v[4], u[4];
#pragma unroll
        for (int j = 0; j < 4; ++j) v[j] = ldp(xr + rcol(j, lane));
        const float rstd = rsqrtf(sumsq4(v) * (1.f / D) + EPS);
#pragma unroll
        for (int j = 0; j < 4; ++j) u[j] = v[j] * rstd * gs[j] + sh[j];
        st_bf16_row(U + (size_t)row * D, lane, u);
    }
}

__device__ __forceinline__ void phase_p6(const Params& p, int G, int wid_s) {
    int tid = wid_s * 64 + lane_id_(); asm volatile("" : "+v"(tid)); const int lane = tid & 63, wave = tid >> 6, gw = blockIdx.x * 8 + wave, NGW = G * 8;
    const float* ada = (const float*)(p.ws + WS_ADA); bf16* U = (bf16*)(p.ws + WS_U); const bf16* MO = (const bf16*)(p.ws + WS_MO);
    const int chunk = (T + NGW - 1) / NGW, rbeg = gw * chunk, rend = (rbeg + chunk < T) ? rbeg + chunk : T;
    int cur = -1; f32x4 q1[4], gs[4], sh[4];
    for (int row = rbeg; row < rend; ++row) {
        const int idx = ada_idx(row);
        if (idx != cur) { cur = idx; const float* a = ada + idx * 6144;
#pragma unroll
            for (int j = 0; j < 4; ++j) { const int c = rcol(j, lane); q1[j] = ldp(a + 2048 + c) * ldp(p.g_post1 + c); gs[j] = ldp(p.g_pre2 + c) * (ldp(a + 4096 + c) + 1.0f); sh[j] = ldp(a + 3072 + c); } }
        const float* xr = xrow_ptr(p, row); f32x4 v[4], h[4], u[4];
        ld_bf16_row(MO + (size_t)row * D, lane, v);
#pragma unroll
        for (int j = 0; j < 4; ++j) h[j] = ldp(xr + rcol(j, lane));
        const float rstd = rsqrtf(sumsq4(v) * (1.f / D) + EPS);
#pragma unroll
        for (int j = 0; j < 4; ++j) h[j] = h[j] + q1[j] * (v[j] * rstd);
        const float rstd2 = rsqrtf(sumsq4(h) * (1.f / D) + EPS);
#pragma unroll
        for (int j = 0; j < 4; ++j) u[j] = h[j] * rstd2 * gs[j] + sh[j];
        st_bf16_row(U + (size_t)row * D, lane, u);
    }
}
__device__ __forceinline__ void phase_p10(const Params& p, int G, int wid_s) {
    int tid = wid_s * 64 + lane_id_(); asm volatile("" : "+v"(tid)); const int lane = tid & 63, wave = tid >> 6, gw = blockIdx.x * 8 + wave, NGW = G * 8;
    const float* ada = (const float*)(p.ws + WS_ADA); const bf16* DN = (const bf16*)(p.ws + WS_U); const bf16* MO = (const bf16*)(p.ws + WS_MO);
    const int chunk = (T + NGW - 1) / NGW, rbeg = gw * chunk, rend = (rbeg + chunk < T) ? rbeg + chunk : T;
    int cur = -1; f32x4 q1[4], q2[4];
    for (int row = rbeg; row < rend; ++row) {
        const int idx = ada_idx(row);
        if (idx != cur) { cur = idx; const float* a = ada + idx * 6144;
#pragma unroll
            for (int j = 0; j < 4; ++j) { const int c = rcol(j, lane); q1[j] = ldp(a + 2048 + c) * ldp(p.g_post1 + c); q2[j] = ldp(a + 5120 + c) * ldp(p.g_post2 + c); } }
        const float* xr = xrow_ptr(p, row); f32x4 v[4], d[4], h[4];
        ld_bf16_row(MO + (size_t)row * D, lane, v); ld_bf16_row(DN + (size_t)row * D, lane, d);
#pragma unroll
        for (int j = 0; j < 4; ++j) h[j] = ldp(xr + rcol(j, lane));
        const float rstd1 = rsqrtf(sumsq4(v) * (1.f / D) + EPS), rstd2 = rsqrtf(sumsq4(d) * (1.f / D) + EPS);
#pragma unroll
        for (int j = 0; j < 4; ++j) *(f32x4*)(p.out + (size_t)row * D + rcol(j, lane)) = (h[j] + q1[j] * (v[j] * rstd1)) + q2[j] * (d[j] * rstd2);
    }
}

__device__ __forceinline__ void unpack8(const u32x4 w, float (&x)[8]) { x[0] = bflo(w.x); x[1] = bfhi(w.x); x[2] = bflo(w.y); x[3] = bfhi(w.y); x[4] = bflo(w.z); x[5] = bfhi(w.z); x[6] = bflo(w.w); x[7] = bfhi(w.w); }
__device__ __forceinline__ u32x4 pack8(const float (&x)[8]) { u32x4 w; w.x = pk2(x[0], x[1]); w.y = pk2(x[2], x[3]); w.z = pk2(x[4], x[5]); w.w = pk2(x[6], x[7]); return w; }

__device__ __forceinline__ void head_norm_rope(float (&x)[8], const float* gain, int e, bool rope, int t, const LAS float* tab) {
    float ss = 0.f;
#pragma unroll
    for (int j = 0; j < 8; ++j) ss += x[j] * x[j];
    ss += __shfl_xor(ss, 1); ss += __shfl_xor(ss, 2); ss += __shfl_xor(ss, 4);
    const float rstd = rsqrtf(ss * (1.f / 64.f) + EPS);
#pragma unroll
    for (int j = 0; j < 8; ++j) x[j] = x[j] * rstd * gain[e * 8 + j];
    float other[8];
#pragma unroll
    for (int j = 0; j < 8; ++j) other[j] = __shfl_xor(x[j], 2);
    if (rope) {
        const int pos = (e < 4) ? (t >> 6) : (t & 63); const LAS float* cs = tab + pos * 32 + 8 * (e & 1); const float sgn = (e & 2) ? 1.f : -1.f;
#pragma unroll
        for (int j = 0; j < 8; ++j) x[j] = x[j] * cs[j] + sgn * other[j] * cs[16 + j];
    }
}

__device__ __forceinline__ void phase_p2(const Params& p, LAS unsigned char* lds, int G, int wid_s) {
    int tid = wid_s * 64 + lane_id_(); asm volatile("" : "+v"(tid));
    const bf16* CX = (const bf16*)(p.ws + WS_CX); bf16* B = (bf16*)(p.ws + WS_B);
    float w0[8], w1[8], w2[8];
    { const int c0 = ((blockIdx.x * NTHR + tid) & 127) * 8;
#pragma unroll
      for (int j = 0; j < 8; ++j) { w0[j] = p.conv_w[c0 + j]; w1[j] = p.conv_w[D + c0 + j]; w2[j] = p.conv_w[2 * D + c0 + j]; } }
    for (int idx = blockIdx.x * NTHR + tid; idx < (T / 8) * 128; idx += G * NTHR) {
        const int tb = idx >> 7, cgp = idx & 127, row0 = tb * 8, c0 = cgp * 8;
        const int sbeg = row0 < TP ? (row0 & ~255) : (TP + ((row0 - TP) & ~2047)), send = sbeg + (row0 < TP ? 256 : 2048);
        u32x4 cr[10], br[8];
#pragma unroll
        for (int i = 0; i < 10; ++i) { int r = row0 - 1 + i; r = r < sbeg ? sbeg : (r >= send ? send - 1 : r); cr[i] = *(const u32x4*)(CX + (size_t)r * D + c0); }
#pragma unroll
        for (int i = 0; i < 8; ++i) br[i] = *(const u32x4*)(B + (size_t)(row0 + i) * D + c0);
        if (row0 == sbeg) cr[0] = (u32x4){0u, 0u, 0u, 0u};
        if (row0 + 8 == send) cr[9] = (u32x4){0u, 0u, 0u, 0u};
        float prev[8], cur[8], nxt[8];
        unpack8(cr[0], prev); unpack8(cr[1], cur);
#pragma unroll
        for (int i = 0; i < 8; ++i) {
            unpack8(cr[i + 2], nxt); float bb[8]; unpack8(br[i], bb);
#pragma unroll
            for (int j = 0; j < 8; ++j) { bb[j] *= (w0[j] * prev[j] + w1[j] * cur[j] + w2[j] * nxt[j]); prev[j] = cur[j]; cur[j] = nxt[j]; }
            *(u32x4*)(B + (size_t)(row0 + i) * D + c0) = pack8(bb);
        }
    }
}

__device__ __forceinline__ void phase_p8(const Params& p, int r0, int G, int wid_s) {
    int tid = wid_s * 64 + lane_id_(); asm volatile("" : "+v"(tid));
    const bf16* UP = (const bf16*)(p.ws + WS_UP); bf16* ACT = (bf16*)(p.ws + WS_ACT);
    constexpr int NCG = DFF / 8;
    for (int idx = blockIdx.x * NTHR + tid; idx < (CHUNK / 8) * NCG; idx += G * NTHR) {
        const int tb = idx / NCG, cgp = idx - tb * NCG, lrow0 = tb * 8, row0 = r0 + lrow0, c0 = cgp * 8;
        const int sbeg = row0 < TP ? (row0 & ~255) : (TP + ((row0 - TP) & ~2047)), send = sbeg + (row0 < TP ? 256 : 2048);
        u32x4 gr[10], vr[10];
#pragma unroll
        for (int i = 0; i < 10; ++i) { int r = row0 - 1 + i; r = r < sbeg ? sbeg : (r >= send ? send - 1 : r); const bf16* q = UP + (size_t)(r - r0) * NUP + c0; gr[i] = *(const u32x4*)q; vr[i] = *(const u32x4*)(q + DFF); }
        float wg0[8], wg1[8], wg2[8], wv0[8], wv1[8], wv2[8];
#pragma unroll
        for (int j = 0; j < 8; ++j) { wg0[j] = p.conv_ffn[c0 + j]; wg1[j] = p.conv_ffn[NUP + c0 + j]; wg2[j] = p.conv_ffn[2 * NUP + c0 + j];
            wv0[j] = p.conv_ffn[DFF + c0 + j]; wv1[j] = p.conv_ffn[NUP + DFF + c0 + j]; wv2[j] = p.conv_ffn[2 * NUP + DFF + c0 + j]; }
        if (row0 == sbeg) { gr[0] = (u32x4){0u, 0u, 0u, 0u}; vr[0] = gr[0]; }
        if (row0 + 8 == send) { gr[9] = (u32x4){0u, 0u, 0u, 0u}; vr[9] = gr[9]; }
        float gp[8], gc[8], gn[8], vp[8], vc[8], vn[8];
        unpack8(gr[0], gp); unpack8(gr[1], gc); unpack8(vr[0], vp); unpack8(vr[1], vc);
#pragma unroll
        for (int i = 0; i < 8; ++i) {
            unpack8(gr[i + 2], gn); unpack8(vr[i + 2], vn);
            float o[8];
#pragma unroll
            for (int j = 0; j < 8; ++j) { const float g = wg0[j] * gp[j] + wg1[j] * gc[j] + wg2[j] * gn[j], v = wv0[j] * vp[j] + wv1[j] * vc[j] + wv2[j] * vn[j];
                o[j] = g * sigmoidf_(g) * v; gp[j] = gc[j]; gc[j] = gn[j]; vp[j] = vc[j]; vc[j] = vn[j]; }
            *(u32x4*)(ACT + (size_t)(lrow0 + i) * DFF + c0) = pack8(o);
        }
    }
}

__device__ __forceinline__ void phase_fix(const Params& p, int G, int wid_s) {
    int tid = wid_s * 64 + lane_id_(); asm volatile("" : "+v"(tid));
    const float* HALO = (const float*)(p.ws + WS_HALO); bf16* ACT = (bf16*)(p.ws + WS_ACTF); const float* cf = p.conv_ffn;
    for (int idx = blockIdx.x * NTHR + tid; idx < 56 * (DFF / 4); idx += G * NTHR) {
        const int bnd = idx / (DFF / 4), j = (idx - bnd * (DFF / 4)) * 4, pm = 16 + (bnd / 7) * 8 + (bnd % 7);
        const float* L = HALO + (size_t)((pm * 2 + 1) * 4) * DFF + j; const float* F = HALO + (size_t)(((pm + 1) * 2 + 0) * 4) * DFF + j;
        const f32x4 Lpg = *(const f32x4*)L, Lpv = *(const f32x4*)(L + DFF), Lrg = *(const f32x4*)(L + 2 * DFF), Lrv = *(const f32x4*)(L + 3 * DFF);
        const f32x4 Fpg = *(const f32x4*)F, Fpv = *(const f32x4*)(F + DFF), Frg = *(const f32x4*)(F + 2 * DFF), Frv = *(const f32x4*)(F + 3 * DFF);
        const f32x4 wg0 = *(const f32x4*)(cf + j), wg2 = *(const f32x4*)(cf + 2 * NUP + j), wv0 = *(const f32x4*)(cf + DFF + j), wv2 = *(const f32x4*)(cf + 2 * NUP + DFF + j);
        const f32x4 gA = Lpg + wg2 * Frg, vA = Lpv + wv2 * Frv, gB = Fpg + wg0 * Lrg, vB = Fpv + wv0 * Lrv;
        const f32x4 aA = gA * sig4(gA) * vA, aB = gB * sig4(gB) * vB;
        u32x2 w; w.x = pk2(aA[0], aA[1]); w.y = pk2(aA[2], aA[3]); *(u32x2*)(ACT + (size_t)(pm * 256 + 255) * DFF + j) = w;
        w.x = pk2(aB[0], aB[1]); w.y = pk2(aB[2], aB[3]); *(u32x2*)(ACT + (size_t)((pm + 1) * 256) * DFF + j) = w;
    }
}

typedef short v4i16_t __attribute__((ext_vector_type(4)));
__device__ __forceinline__ s16x4 vtr(const LAS unsigned char* p) { return __builtin_bit_cast(s16x4, __builtin_amdgcn_ds_read_tr16_b64_v4i16((LAS v4i16_t*)p)); }
__device__ __forceinline__ bf16x8 pkfrag(float a, float b, float c, float d, float e, float f, float g, float h) {
    u32x4 w; w.x = pk2(a, b); w.y = pk2(c, d); w.z = pk2(e, f); w.w = pk2(g, h); return __builtin_bit_cast(bf16x8, w); }

__device__ __forceinline__ float max3f(float a, float b, float c) { float r; asm("v_max3_f32 %0, %1, %2, %3" : "=v"(r) : "v"(a), "v"(b), "v"(c)); return r; }
__device__ __forceinline__ void attn_unit(const bf16* Qg, bf16* Og, const bf16* Kg, const bf16* Vg, int L, int kvh, float kbound, LAS unsigned char* lds, int wid_s) {
    int tid = wid_s * 64 + lane_id_(); asm volatile("" : "+v"(tid)); const int lane = tid & 63, r32 = lane & 31, hi = lane >> 5, wid = __builtin_amdgcn_readfirstlane(tid >> 6);
    const int head = kvh * 4 + (wid >> 1), qrow0 = (wid & 1) * 32;
    const bf16* qp = Qg + (size_t)(qrow0 + r32) * D + head * 64 + hi * 8;
    bf16x8 qr[4];
#pragma unroll
    for (int d0 = 0; d0 < 4; ++d0) qr[d0] = *(const bf16x8*)(qp + d0 * 16);
    float qn2 = 0.f;
#pragma unroll
    for (int d0 = 0; d0 < 4; ++d0) { const u32x4 w = __builtin_bit_cast(u32x4, qr[d0]); const float a0 = bflo(w.x), a1 = bfhi(w.x), a2 = bflo(w.y), a3 = bfhi(w.y), a4 = bflo(w.z), a5 = bfhi(w.z), a6 = bflo(w.w), a7 = bfhi(w.w);
        qn2 += ((a0 * a0 + a1 * a1) + (a2 * a2 + a3 * a3)) + ((a4 * a4 + a5 * a5) + (a6 * a6 + a7 * a7)); }
    qn2 = lsum32(qn2);
    const float nm = -(sqrtf(qn2) * kbound);
    f32x16 negm;
#pragma unroll
    for (int r = 0; r < 16; ++r) negm[r] = nm;
    const int skey = tid >> 3, sch = tid & 7;
    const bf16* kg = Kg + (size_t)skey * KVW + kvh * 64 + sch * 8;
    const bf16* vg = Vg + (size_t)skey * KVW + kvh * 64 + sch * 8;
    const int kdst = (skey * 128 + ((sch ^ (skey & 7)) * 16)) ^ (((skey >> 3) & 1) << 7);
    const int vdst = 8192 + skey * 128 + (((sch >> 2) ^ ((skey >> 1) & 1)) * 64) + (sch & 3) * 16;
    const int NT = L >> 6;
    const int koff = r32 * 128, ksw = r32 & 7, kx = ((r32 >> 3) & 1) << 7;
    const int g4 = lane >> 4, i16 = lane & 15, q_ = i16 >> 2, p_ = i16 & 3;
    const int vb0 = 8192 + (4 * hi + q_) * 128 + ((q_ >> 1) * 64) + (16 * (g4 & 1) + 4 * p_) * 2, vb1 = vb0 ^ 64;
    f32x16 o0 = {}, o1 = {}, o2 = {}; unsigned one2 = 0x3F803F80u; asm volatile("" : "+v"(one2)); const bf16x8 ones = __builtin_bit_cast(bf16x8, (u32x4){one2, one2, one2, one2});
    auto qk = [&](const LAS unsigned char* kbuf, f32x16& s0, f32x16& s1) {
#pragma unroll
        for (int d0 = 0; d0 < 4; ++d0) { const int off = (koff + (((2 * d0 + hi) ^ ksw) * 16)) ^ kx;
            const bf16x8 a0 = *(const LAS bf16x8*)(kbuf + off), a1 = *(const LAS bf16x8*)(kbuf + off + 4096);
            s0 = __builtin_amdgcn_mfma_f32_32x32x16_bf16(a0, qr[d0], d0 == 0 ? negm : s0, 0, 0, 0); s1 = __builtin_amdgcn_mfma_f32_32x32x16_bf16(a1, qr[d0], d0 == 0 ? negm : s1, 0, 0, 0); }
    };
    u32x4 kA = *(const u32x4*)kg, vA = *(const u32x4*)vg, kB = *(const u32x4*)(kg + (size_t)64 * KVW);
    *(LAS u32x4*)(lds + kdst) = kA; *(LAS u32x4*)(lds + vdst) = vA; *(LAS u32x4*)(lds + 16384 + kdst) = kB;
    kA = *(const u32x4*)(kg + (size_t)2 * 64 * KVW); vA = *(const u32x4*)(vg + (size_t)1 * 64 * KVW);
    kB = *(const u32x4*)(kg + (size_t)3 * 64 * KVW); u32x4 vB = *(const u32x4*)(vg + (size_t)2 * 64 * KVW);
    __syncthreads();
    f32x16 s0, s1;
    qk(lds, s0, s1);
    LDS_WAIT();
    __syncthreads();
    auto tile = [&](int t, u32x4& kw, u32x4& vw) {
        const LAS unsigned char* vbuf = lds + (t & 1) * 16384; LAS unsigned char* obuf = lds + ((t + 1) & 1) * 16384;
        bf16x8 kf0[4], kf1[4]; s16x4 vl0[4], vh0[4], vl1[4], vh1[4];
#pragma unroll
        for (int d0 = 0; d0 < 4; ++d0) { const int off = (koff + (((2 * d0 + hi) ^ ksw) * 16)) ^ kx; kf0[d0] = *(const LAS bf16x8*)(obuf + off); kf1[d0] = *(const LAS bf16x8*)(obuf + off + 4096); }
#pragma unroll
        for (int ks = 0; ks < 4; ++ks) { vl0[ks] = vtr(vbuf + vb0 + ks * 2048); vh0[ks] = vtr(vbuf + vb0 + ks * 2048 + 1024); vl1[ks] = vtr(vbuf + vb1 + ks * 2048); vh1[ks] = vtr(vbuf + vb1 + ks * 2048 + 1024); }
        __builtin_amdgcn_sched_barrier(0);
        f32x16 n0, n1;
#pragma unroll
        for (int d0 = 0; d0 < 4; ++d0) { n0 = __builtin_amdgcn_mfma_f32_32x32x16_bf16(kf0[d0], qr[d0], d0 == 0 ? negm : n0, 0, 0, 0); n1 = __builtin_amdgcn_mfma_f32_32x32x16_bf16(kf1[d0], qr[d0], d0 == 0 ? negm : n1, 0, 0, 0); }
#pragma unroll
        for (int r = 0; r < 16; ++r) { s0[r] = fexp2(s0[r]); s1[r] = fexp2(s1[r]); }
        bf16x8 pb[4];
        pb[0] = pkfrag(s0[0], s0[1], s0[2], s0[3], s0[4], s0[5], s0[6], s0[7]); pb[1] = pkfrag(s0[8], s0[9], s0[10], s0[11], s0[12], s0[13], s0[14], s0[15]);
        pb[2] = pkfrag(s1[0], s1[1], s1[2], s1[3], s1[4], s1[5], s1[6], s1[7]); pb[3] = pkfrag(s1[8], s1[9], s1[10], s1[11], s1[12], s1[13], s1[14], s1[15]);
#pragma unroll
        for (int ks = 0; ks < 4; ++ks) {
            const bf16x8 a0 = (bf16x8){vl0[ks][0], vl0[ks][1], vl0[ks][2], vl0[ks][3], vh0[ks][0], vh0[ks][1], vh0[ks][2], vh0[ks][3]}, a1 = (bf16x8){vl1[ks][0], vl1[ks][1], vl1[ks][2], vl1[ks][3], vh1[ks][0], vh1[ks][1], vh1[ks][2], vh1[ks][3]};
            o0 = __builtin_amdgcn_mfma_f32_32x32x16_bf16(a0, pb[ks], o0, 0, 0, 0); o1 = __builtin_amdgcn_mfma_f32_32x32x16_bf16(a1, pb[ks], o1, 0, 0, 0);
            o2 = __builtin_amdgcn_mfma_f32_32x32x16_bf16(ones, pb[ks], o2, 0, 0, 0);
        }
        *(LAS u32x4*)(lds + (t & 1) * 16384 + kdst) = kw;
        *(LAS u32x4*)(obuf + vdst) = vw;
        { const int tk = (t + 4 < NT) ? t + 4 : NT - 1, tv = (t + 3 < NT) ? t + 3 : NT - 1;
          kw = *(const u32x4*)(kg + (size_t)tk * 64 * KVW); vw = *(const u32x4*)(vg + (size_t)tv * 64 * KVW); }
        __syncthreads();
        s0 = n0; s1 = n1;
    };
#pragma unroll 1
    for (int t = 0; t < NT; t += 2) { tile(t, kA, vA); tile(t + 1, kB, vB); }
    const float inv = 1.f / o2[0];
    LAS unsigned char* st = lds + wid * 4608;
#pragma unroll
    for (int g = 0; g < 4; ++g) { const int d = 8 * g + 4 * hi;
        u32x2 w; w.x = pk2(o0[4 * g] * inv, o0[4 * g + 1] * inv); w.y = pk2(o0[4 * g + 2] * inv, o0[4 * g + 3] * inv); *(LAS u32x2*)(st + r32 * 144 + d * 2) = w;
        w.x = pk2(o1[4 * g] * inv, o1[4 * g + 1] * inv); w.y = pk2(o1[4 * g + 2] * inv, o1[4 * g + 3] * inv); *(LAS u32x2*)(st + r32 * 144 + (32 + d) * 2) = w; }
    LDS_WAIT();
#pragma unroll
    for (int it = 0; it < 4; ++it) { const int id = it * 64 + lane, q = id >> 3, c = id & 7;
        const u32x4 v = *(const LAS u32x4*)(st + q * 144 + c * 16); *(u32x4*)(Og + (size_t)(qrow0 + q) * D + head * 64 + c * 8) = v; }
    __syncthreads();
}

__device__ __forceinline__ void phase_attn(const Params& p, LAS unsigned char* lds, int G, int wid_s) {
    const bf16* Q = (const bf16*)(p.ws + WS_Q); bf16* O = (bf16*)(p.ws + WS_U);
    const bf16 *Kp = (const bf16*)(p.ws + WS_KP), *Vp = (const bf16*)(p.ws + WS_VP), *Ks = (const bf16*)(p.ws + WS_KS), *Vs = (const bf16*)(p.ws + WS_VS);
    int tl = lane_id_(); asm volatile("" : "+v"(tl));
    float gk = fabsf(p.k_norm[tl & 63]);
    gk = wave_max(gk);
    const int klat_i = __builtin_amdgcn_readfirstlane(__builtin_bit_cast(int, 8.f * gk));
    const float* kmax = (const float*)(p.ws + WS_KMAX);
    const int vcu = (G % 8 == 0) ? ((int)(blockIdx.x % 8) * (G / 8) + (int)(blockIdx.x / 8)) : (int)blockIdx.x;
    for (int u = vcu; u < 1280; u += G) {
        int ki = __builtin_amdgcn_readfirstlane(klat_i); asm volatile("" : "+s"(ki)); const float klat = __builtin_bit_cast(float, ki);
        if (u < 1024) { const int b = u >> 7, kvh = (u >> 5) & 3, qb = u & 31; const size_t r = (size_t)(TP + b * 2048 + qb * 64) * D;
            attn_unit(Q + r, O + r, Ks + (size_t)b * LSAMP * KVW, Vs + (size_t)b * LSAMP * KVW, LSAMP, kvh, 1.01f * fmaxf(klat, kmax[b * 4 + kvh]), lds, wid_s); }
        else { const int v = u - 1024, s = v >> 4, kvh = (v >> 2) & 3, qb = v & 3; const size_t r = (size_t)(s * 256 + qb * 64) * D;
            attn_unit(Q + r, O + r, Kp + (size_t)s * 256 * KVW, Vp + (size_t)s * 256 * KVW, 256, kvh, 1.01f * klat, lds, wid_s); }
    }
}

struct WOrder : pg8::StaticOrder { int wid; };

#ifndef PROG_LIST
#define PROG_LIST 0,1,2,3,5,6,7,8,9,10,11,15
#endif
__constant__ unsigned char PROG[] = {PROG_LIST};
__global__ void __launch_bounds__(NTHR, 2) fwd_megakernel(Params p_arg) {
#if defined(__HIP_DEVICE_COMPILE__)
    extern __shared__ __attribute__((aligned(16))) unsigned char lds_raw[];
    LAS unsigned char* lds = (LAS unsigned char*)lds_raw;
    cg::grid_group grid = cg::this_grid();
    const int G = gridDim.x;
    volatile LAS unsigned* bst = (volatile LAS unsigned*)(lds + LDS_BYTES - 64);
    if (threadIdx.x < 16) bst[threadIdx.x] = 0u;
    { LAS float* tab = (LAS float*)(lds + 131072 + 8192);
      for (int i = threadIdx.x; i < 1024; i += NTHR) { const int pos = i >> 4, k = i & 15; const float ang = (float)pos * fexp2(-(float)k * (13.287712379549449f / 16.f)); tab[pos * 32 + k] = __cosf(ang); tab[pos * 32 + 16 + k] = __sinf(ang); } }
    __syncthreads();
    const int wid_s = __builtin_amdgcn_readfirstlane((int)(threadIdx.x >> 6));
    const XcdBarrier bar = xcd_barrier_post((unsigned*)(p_arg.ws + WS_BAR), bst, wid_s);
    constexpr int NSTEP = sizeof(PROG);
    { const Params p0 = p_arg; phase_p0(p0, lds, G, wid_s); }
    if (G > (1 << 20)) grid.sync(); else xcd_barrier(bar);
#pragma unroll 1
    for (int pc = 1; pc < NSTEP; ++pc) {
        int step = __builtin_amdgcn_readfirstlane((int)PROG[pc]);
        asm volatile("" : "+s"(step));
        const __attribute__((address_space(4))) Params* kp = (const __attribute__((address_space(4))) Params*)__builtin_amdgcn_kernarg_segment_ptr();
        asm volatile("" : "+s"(kp));
        const Params p = *kp; unsigned char* ws = p.ws;
        const bf16* A = nullptr; const bf16* Bt = nullptr; int M = 0, N = 0, K = 0; bool is_gemm = true;
        EpiU e; e.mode = 1; e.ld = D; e.O = nullptr; e.rowoff = 0; e.X1 = nullptr; e.X2 = nullptr; e.xl = lds + 131072; e.kp = kp;
        bf16 *U = (bf16*)(ws + WS_U), *Q = (bf16*)(ws + WS_Q), *CX = (bf16*)(ws + WS_CX), *B = (bf16*)(ws + WS_B);
        switch (step) {
            case 1: phase_u1(p, G, wid_s); is_gemm = false; break;
            case 2: A = U; Bt = (const bf16*)(ws + WS_WIN); M = T; N = NIN; K = D; e.mode = 0; break;
            case 3: phase_p2(p, lds, G, wid_s); phase_attn(p, lds, G, wid_s); is_gemm = false; break;
            case 5: A = U; Bt = (const bf16*)(ws + WS_WATT); M = T; N = D; K = D; e.mode = 2; e.X1 = (const bf16*)p.out; e.O = CX; break;
            case 6: A = B; Bt = (const bf16*)(ws + WS_WCONV); M = T; N = D; K = D; e.mode = 3; e.X1 = (const bf16*)((const unsigned char*)p.out + (size_t)T * D); e.X2 = CX; e.O = Q; break;
            case 7: A = Q; Bt = (const bf16*)(ws + WS_WO); M = T; N = D; K = D; e.O = (bf16*)(ws + WS_MO); break;
            case 8: phase_p6(p, G, wid_s); is_gemm = false; break;
            case 9: A = U; Bt = (const bf16*)(ws + WS_WUP); M = T; N = NUP; K = D; e.mode = 5; break;
            case 10: phase_fix(p, G, wid_s); is_gemm = false; break;
            case 11: A = (const bf16*)(ws + WS_ACTF); Bt = (const bf16*)(ws + WS_WDN); M = T; N = D; K = DFF; e.O = U; break;
            case 15: phase_p10(p, G, wid_s); is_gemm = false; break;
            default: is_gemm = false; break;
        }
        if (is_gemm) { pg8::Gemm g{A, Bt, M, N, K}; WOrder S; S.init(M, N, G, (int)blockIdx.x); S.wid = wid_s; pg8::gemm_phase<EpiU, WOrder, true, true>(lds, g, S, e); }
        if (pc + 1 < NSTEP) xcd_barrier(bar);
    }
#endif
}

extern "C" void kernel_launch(void* const* d_in, const int* in_sizes, int n_in, void* d_out, int out_size, void* d_ws, size_t ws_size, hipStream_t stream) {
    static int grid_blocks = 0;
    if (!grid_blocks) {
        int dev = 0, cus = 0, per_cu = 0;
        hipGetDevice(&dev);
        hipDeviceGetAttribute(&cus, hipDeviceAttributeMultiprocessorCount, dev);
        hipFuncSetAttribute((const void*)fwd_megakernel, hipFuncAttributeMaxDynamicSharedMemorySize, LDS_BYTES);
        hipOccupancyMaxActiveBlocksPerMultiprocessor(&per_cu, (const void*)fwd_megakernel, NTHR, LDS_BYTES);
        if (per_cu < 1) per_cu = 1;
        grid_blocks = cus * per_cu;
        (void)hipGetLastError();
    }
    Params p{};
    const float** pp = (const float**)&p;
    for (int i = 0; i < 22; ++i) pp[i] = (const float*)d_in[i];
    p.out = (float*)d_out; p.ws = (unsigned char*)d_ws;
    (void)hipMemsetAsync((unsigned char*)d_ws + WS_BAR, 0, WS_BAR_BYTES, stream);
    void* args[] = {&p};
    hipError_t e = hipLaunchCooperativeKernel((const void*)fwd_megakernel, dim3(grid_blocks), dim3(NTHR), args, LDS_BYTES, stream);
    if (e != hipSuccess) fprintf(stderr, "cooperative launch failed: %s (grid %d)\n", hipGetErrorString(e), grid_blocks);
}
```
